# Optimizing an MI355X kernel written in HIP

```python
import jax, jax.numpy as jnp
from jax import lax
import numpy as np

D_MODEL = 1024
BATCH = 8
SEQ = 4096
DEPTH = 2

GRID_W = 64
CTX_LEN = 256
N_MIXERS = 2
N_RET = (DEPTH + 1) // 2
N_MLA = DEPTH // 2
EPS = 1e-6
ROPE_BASE = 10000.0
RET_HEADS = 4
RET_DK = D_MODEL // RET_HEADS
RET_DV = 2 * RET_DK
RET_VW = RET_HEADS * RET_DV
RET_CHUNK = 128
RET_IN = 2 * D_MODEL + 3 * RET_VW
MLA_HEADS = 8
MLA_NOPE = 128
MLA_ROPE = 64
MLA_QK = MLA_NOPE + MLA_ROPE
MLA_V = 128
MLA_Q_RANK = 384
MLA_KV_RANK = 256
MLA_IN = MLA_Q_RANK + MLA_KV_RANK + MLA_ROPE
ATTN_BLOCK = 128
N_EXPERTS = 64
TOP_K = 8
N_GROUPS = 8
TOPK_GROUPS = 4
EXPERT_FF = 256
SHARED_FF = 256
ROUTED_SCALE = 2.5

kernel_name = 'hybrid_retention_mla_moe_dit'


def rms_scale(x):
    xf = x.astype(jnp.float32)
    return (xf * lax.rsqrt(jnp.mean(xf * xf, axis=-1, keepdims=True) + EPS)).astype(x.dtype)


def rmsnorm(x, g):
    return rms_scale(x) * g


def modulate(h, shift, scale):
    return h * (1 + scale) + shift


def axial_angles(rows_n, rot_dim):
    axis_dim = rot_dim // 2
    inv = ROPE_BASE ** (-jnp.arange(0, axis_dim, 2, dtype=jnp.float32) / axis_dim)
    row = jnp.repeat(jnp.arange(rows_n, dtype=jnp.float32), GRID_W)
    col = jnp.tile(jnp.arange(GRID_W, dtype=jnp.float32), rows_n)
    return row[:, None] * inv, col[:, None] * inv


def rotate_half(x, ang):
    x1, x2 = jnp.split(x, 2, axis=-1)
    cos = jnp.cos(ang)[None, :, None, :].astype(x.dtype)
    sin = jnp.sin(ang)[None, :, None, :].astype(x.dtype)
    return jnp.concatenate([x1 * cos - x2 * sin, x2 * cos + x1 * sin], axis=-1)


def axial_rope(x, ang_r, ang_c):
    xr, xc = jnp.split(x, 2, axis=-1)
    return jnp.concatenate([rotate_half(xr, ang_r), rotate_half(xc, ang_c)], axis=-1)


def retention_scan(q, k, v, log_gamma, s0):
    b, L, H, _ = q.shape
    dv = v.shape[-1]
    nc = L // RET_CHUNK

    def chunks(t):
        return t.reshape(b, nc, RET_CHUNK, H, t.shape[-1]).transpose(1, 0, 2, 3, 4)

    idx = jnp.arange(RET_CHUNK, dtype=jnp.float32)
    rel = idx[:, None] - idx[None, :]
    lg = log_gamma.astype(jnp.float32)
    intra = jnp.where(rel[None] >= 0, jnp.exp(lg[:, None, None] * jnp.maximum(rel, 0.0)[None]), 0.0).astype(q.dtype)
    dec_q = jnp.exp(lg[:, None] * (idx + 1)[None]).T[None, :, :, None].astype(q.dtype)
    dec_k = jnp.exp(lg[:, None] * (RET_CHUNK - 1 - idx)[None]).T[None, :, :, None].astype(q.dtype)
    dec_chunk = jnp.exp(lg * RET_CHUNK)[None, :, None, None].astype(q.dtype)

    def step(S, qkv):
        qc, kc, vc = qkv
        scores = jnp.einsum('bihd,bjhd->bhij', qc, kc) * intra
        y = jnp.einsum('bhij,bjhv->bihv', scores, vc) + jnp.einsum('bihd,bhdv->bihv', qc, S) * dec_q
        S = S * dec_chunk + jnp.einsum('bjhd,bjhv->bhdv', kc * dec_k, vc)
        return S, y

    S, ys = lax.scan(step, s0, (chunks(q), chunks(k), chunks(v)))
    return ys.transpose(1, 0, 2, 3, 4).reshape(b, L, H, dv), S


def bidir_retention(q, k, v, lg_f, lg_b, s0_f, s0_b):
    y_f, s_f = retention_scan(q, k, v, lg_f, s0_f)
    y_b, s_b = retention_scan(q[:, ::-1], k[:, ::-1], v[:, ::-1], lg_b, s0_b)
    return y_f, y_b[:, ::-1], s_f, s_b


def retention_mixer(h_lat, h_ctx, w_in, decay_f, decay_b, w_o, ang_r, ang_c, need_ctx_out):
    lg_f = -jnp.exp(decay_f.astype(jnp.float32))
    lg_b = -jnp.exp(decay_b.astype(jnp.float32))

    def project(h, rotate):
        b, L, _ = h.shape
        q, k, v, g_f, g_b = jnp.split(h @ w_in, [D_MODEL, 2 * D_MODEL, 2 * D_MODEL + RET_VW, 2 * D_MODEL + 2 * RET_VW], axis=-1)
        q = q.reshape(b, L, RET_HEADS, RET_DK)
        k = k.reshape(b, L, RET_HEADS, RET_DK)
        v = v.reshape(b, L, RET_HEADS, RET_DV)
        if rotate:
            q = axial_rope(q, ang_r, ang_c)
            k = axial_rope(k, ang_r, ang_c)
        return q, k * RET_DK ** -0.5, v, g_f, g_b

    def readout(y_f, y_b, g_f, g_b):
        b, L = g_f.shape[:2]
        o = jax.nn.silu(g_f) * rms_scale(y_f).reshape(b, L, RET_VW) + jax.nn.silu(g_b) * rms_scale(y_b).reshape(b, L, RET_VW)
        return o @ w_o

    qc, kc, vc, gfc, gbc = project(h_ctx, False)
    s0 = jnp.zeros((h_ctx.shape[0], RET_HEADS, RET_DK, RET_DV), h_ctx.dtype)
    yc_f, yc_b, sc_f, sc_b = bidir_retention(qc, kc, vc, lg_f, lg_b, s0, s0)
    ql, kl, vl, gfl, gbl = project(h_lat, True)
    yl_f, yl_b, _, _ = bidir_retention(ql, kl, vl, lg_f, lg_b, sc_f, sc_b)
    out_lat = readout(yl_f, yl_b, gfl, gbl)
    out_ctx = readout(yc_f, yc_b, gfc, gbc) if need_ctx_out else None
    return out_lat, out_ctx


def attend(q, k, v):
    s = jnp.einsum('bqhd,bkhd->bhqk', q, k).astype(jnp.float32)
    p = jax.nn.softmax(s, axis=-1).astype(v.dtype)
    return jnp.einsum('bhqk,bkhd->bqhd', p, v)


def mla_mixer(h_lat, h_ctx, w_in, q_a_norm, w_q_b, kv_a_norm, w_kv_b, q_norm, k_norm, w_o, ang_r, ang_c, need_ctx_out):
    def queries(a, rotate):
        b, L, _ = a.shape
        q = (rmsnorm(a[..., :MLA_Q_RANK], q_a_norm) @ w_q_b).reshape(b, L, MLA_HEADS, MLA_QK)
        q_nope = rmsnorm(q[..., :MLA_NOPE], q_norm[:MLA_NOPE])
        q_rope = rmsnorm(q[..., MLA_NOPE:], q_norm[MLA_NOPE:])
        if rotate:
            q_rope = axial_rope(q_rope, ang_r, ang_c)
        return jnp.concatenate([q_nope, q_rope], axis=-1) * MLA_QK ** -0.5

    def keys_values(a, rotate):
        b, L, _ = a.shape
        kv_lat = a[..., MLA_Q_RANK:MLA_Q_RANK + MLA_KV_RANK]
        k_rope = a[..., MLA_Q_RANK + MLA_KV_RANK:][:, :, None, :]
        kv = (rmsnorm(kv_lat, kv_a_norm) @ w_kv_b).reshape(b, L, MLA_HEADS, MLA_NOPE + MLA_V)
        k_nope = rmsnorm(kv[..., :MLA_NOPE], k_norm[:MLA_NOPE])
        k_rope = rmsnorm(k_rope, k_norm[MLA_NOPE:])
        if rotate:
            k_rope = axial_rope(k_rope, ang_r, ang_c)
        k = jnp.concatenate([k_nope, jnp.broadcast_to(k_rope, (b, L, MLA_HEADS, MLA_ROPE))], axis=-1)
        return k, kv[..., MLA_NOPE:]

    a_c = h_ctx @ w_in
    a_l = h_lat @ w_in
    kc, vc = keys_values(a_c, False)
    kl, vl = keys_values(a_l, True)
    ql = queries(a_l, True)
    k_all = jnp.concatenate([kl, kc], axis=1)
    v_all = jnp.concatenate([vl, vc], axis=1)
    b, S = h_lat.shape[:2]
    nb = S // ATTN_BLOCK
    q_blocks = ql.reshape(b, nb, ATTN_BLOCK, MLA_HEADS, MLA_QK).transpose(1, 0, 2, 3, 4)
    o = lax.map(lambda qb: attend(qb, k_all, v_all), q_blocks)
    o = o.transpose(1, 0, 2, 3, 4).reshape(b, S, MLA_HEADS * MLA_V)
    out_lat = o @ w_o
    if need_ctx_out:
        qc = queries(a_c, False)
        out_ctx = attend(qc, kc, vc).reshape(h_ctx.shape[0], h_ctx.shape[1], MLA_HEADS * MLA_V) @ w_o
    else:
        out_ctx = None
    return out_lat, out_ctx


def moe_ffn(h, router_w, router_bias, w_gu, w_down, sh_gu, sh_down):
    n = h.shape[0]
    s = jax.nn.sigmoid((h @ router_w).astype(jnp.float32))
    sel = s + router_bias.astype(jnp.float32)
    grp = sel.reshape(n, N_GROUPS, N_EXPERTS // N_GROUPS)
    gscore = lax.top_k(grp, 2)[0].sum(-1)
    _, gidx = lax.top_k(gscore, TOPK_GROUPS)
    gmask = jax.nn.one_hot(gidx, N_GROUPS, dtype=jnp.float32).sum(1) > 0
    emask = jnp.repeat(gmask, N_EXPERTS // N_GROUPS, axis=1)
    _, eidx = lax.top_k(jnp.where(emask, sel, -jnp.inf), TOP_K)
    w = jnp.take_along_axis(s, eidx, axis=1)
    w = w / jnp.sum(w, axis=-1, keepdims=True) * ROUTED_SCALE
    flat = eidx.reshape(-1)
    order = jnp.argsort(flat)
    tok = order // TOP_K
    sizes = jnp.bincount(flat, length=N_EXPERTS).astype(jnp.int32)
    gu = lax.ragged_dot(h[tok], w_gu, sizes)
    g, u = jnp.split(gu, 2, axis=-1)
    y = lax.ragged_dot(jax.nn.silu(g) * u, w_down, sizes)
    y = y[jnp.argsort(order)].reshape(n, TOP_K, h.shape[-1])
    routed = jnp.einsum('nkd,nk->nd', y, w.astype(y.dtype))
    gs, us = jnp.split(h @ sh_gu, 2, axis=-1)
    return routed + (jax.nn.silu(gs) * us) @ sh_down


def setup_inputs(seed: int = 0) -> dict:
    key = jax.random.key(seed)
    ks = jax.random.split(key, 32)
    f32 = jnp.float32

    def nrm(k, shape, scale):
        return jax.random.normal(k, shape, f32) * scale

    def gain(k, shape):
        return 1.0 + 0.05 * jax.random.normal(k, shape, f32)

    hh = jnp.arange(RET_HEADS, dtype=f32)
    base_decay = jnp.log(-jnp.log1p(-(2.0 ** (-5.0 - hh))))
    return {
        'x': nrm(ks[0], (BATCH, SEQ, D_MODEL), 1.0),
        'c': nrm(ks[1], (BATCH, D_MODEL), 1.0),
        'ctx': nrm(ks[2], (BATCH, CTX_LEN, D_MODEL), 1.0),
        'c_ctx': nrm(ks[3], (D_MODEL,), 1.0),
        'ada_w': nrm(ks[4], (DEPTH, D_MODEL, 6 * D_MODEL), 0.5 * D_MODEL ** -0.5),
        'ada_b': nrm(ks[5], (DEPTH, 6 * D_MODEL), 0.02),
        'norm_mix': gain(ks[6], (DEPTH, D_MODEL)),
        'norm_ffn': gain(ks[7], (DEPTH, D_MODEL)),
        'ret_w_in': nrm(ks[8], (N_RET, D_MODEL, RET_IN), D_MODEL ** -0.5),
        'ret_decay_f': base_decay[None] + 0.05 * jax.random.normal(ks[9], (N_RET, RET_HEADS), f32),
        'ret_decay_b': base_decay[None] + 0.05 * jax.random.normal(ks[10], (N_RET, RET_HEADS), f32),
        'ret_w_o': nrm(ks[11], (N_RET, RET_VW, D_MODEL), RET_VW ** -0.5),
        'mla_w_in': nrm(ks[12], (N_MLA, D_MODEL, MLA_IN), D_MODEL ** -0.5),
        'mla_q_a_norm': gain(ks[13], (N_MLA, MLA_Q_RANK)),
        'mla_w_q_b': nrm(ks[14], (N_MLA, MLA_Q_RANK, MLA_HEADS * MLA_QK), MLA_Q_RANK ** -0.5),
        'mla_kv_a_norm': gain(ks[15], (N_MLA, MLA_KV_RANK)),
        'mla_w_kv_b': nrm(ks[16], (N_MLA, MLA_KV_RANK, MLA_HEADS * (MLA_NOPE + MLA_V)), MLA_KV_RANK ** -0.5),
        'mla_q_norm': gain(ks[17], (N_MLA, MLA_QK)),
        'mla_k_norm': gain(ks[18], (N_MLA, MLA_QK)),
        'mla_w_o': nrm(ks[19], (N_MLA, MLA_HEADS * MLA_V, D_MODEL), (MLA_HEADS * MLA_V) ** -0.5),
        'router_w': nrm(ks[20], (DEPTH, D_MODEL, N_EXPERTS), D_MODEL ** -0.5),
        'router_bias': nrm(ks[21], (DEPTH, N_EXPERTS), 0.01),
        'exp_w_gu': nrm(ks[22], (DEPTH, N_EXPERTS, D_MODEL, 2 * EXPERT_FF), D_MODEL ** -0.5),
        'exp_w_down': nrm(ks[23], (DEPTH, N_EXPERTS, EXPERT_FF, D_MODEL), EXPERT_FF ** -0.5),
        'sh_w_gu': nrm(ks[24], (DEPTH, D_MODEL, 2 * SHARED_FF), D_MODEL ** -0.5),
        'sh_w_down': nrm(ks[25], (DEPTH, SHARED_FF, D_MODEL), SHARED_FF ** -0.5),
    }


def reference(x, c, ctx, c_ctx, ada_w, ada_b, norm_mix, norm_ffn, ret_w_in, ret_decay_f, ret_decay_b, ret_w_o,
              mla_w_in, mla_q_a_norm, mla_w_q_b, mla_kv_a_norm, mla_w_kv_b, mla_q_norm, mla_k_norm, mla_w_o,
              router_w, router_bias, exp_w_gu, exp_w_down, sh_w_gu, sh_w_down):
    ROWS = x.shape[1] // GRID_W
    ret_r, ret_c = axial_angles(ROWS, RET_DK)
    mla_r, mla_c = axial_angles(ROWS, MLA_ROPE)
    b = x.shape[0]
    n_ctx = ctx.shape[1]
    for i in range(DEPTH):
        need_ctx = i < DEPTH - 1
        j = i // N_MIXERS
        mod_l = (jax.nn.silu(c) @ ada_w[i] + ada_b[i])[:, None, :]
        mod_c = (jax.nn.silu(c_ctx) @ ada_w[i] + ada_b[i])[None, None, :]
        sh_ml, sc_ml, g_ml, sh_fl, sc_fl, g_fl = jnp.split(mod_l, 6, axis=-1)
        sh_mc, sc_mc, g_mc, sh_fc, sc_fc, g_fc = jnp.split(mod_c, 6, axis=-1)
        h_l = modulate(rmsnorm(x, norm_mix[i]), sh_ml, sc_ml)
        h_c = modulate(rmsnorm(ctx, norm_mix[i]), sh_mc, sc_mc)
        if i % N_MIXERS == 0:
            out_l, out_c = retention_mixer(h_l, h_c, ret_w_in[j], ret_decay_f[j], ret_decay_b[j], ret_w_o[j],
                                           ret_r, ret_c, need_ctx)
        else:
            out_l, out_c = mla_mixer(h_l, h_c, mla_w_in[j], mla_q_a_norm[j], mla_w_q_b[j], mla_kv_a_norm[j],
                                     mla_w_kv_b[j], mla_q_norm[j], mla_k_norm[j], mla_w_o[j], mla_r, mla_c, need_ctx)
        x = x + g_ml * out_l
        moe = lambda t: moe_ffn(t, router_w[i], router_bias[i], exp_w_gu[i], exp_w_down[i], sh_w_gu[i], sh_w_down[i])
        f_l_in = modulate(rmsnorm(x, norm_ffn[i]), sh_fl, sc_fl)
        if need_ctx:
            ctx = ctx + g_mc * out_c
            f_c_in = modulate(rmsnorm(ctx, norm_ffn[i]), sh_fc, sc_fc)
            f = lax.map(moe, jnp.concatenate([f_c_in, f_l_in], axis=1))
            ctx = ctx + g_fc * f[:, :n_ctx]
            x = x + g_fl * f[:, n_ctx:]
        else:
            x = x + g_fl * lax.map(moe, f_l_in)
    return x
```

```cpp
#include <hip/hip_runtime.h>
#include <cstdio>
#include <cstdint>

#ifndef MK_ONE_LAUNCH
#define MK_ONE_LAUNCH 1
#endif
#ifndef PROBE_MASK
#define PROBE_MASK 0u
#endif
#define PROBE_REPS(k) (((PROBE_MASK >> (k)) & 1u) ? 2 : 1)
#ifndef MK_LAST_PHASE
#define MK_LAST_PHASE 99
#endif

#define LAS __attribute__((address_space(3)))
#define GAS __attribute__((address_space(1)))
typedef unsigned short bf16_t;
typedef short bf16x8 __attribute__((ext_vector_type(8)));
typedef short s16x4 __attribute__((ext_vector_type(4)));
typedef float f32x4 __attribute__((ext_vector_type(4)));
typedef float f32x2 __attribute__((ext_vector_type(2)));
typedef float f32x16 __attribute__((ext_vector_type(16)));
typedef unsigned u32x4 __attribute__((ext_vector_type(4)));
typedef unsigned u32x2 __attribute__((ext_vector_type(2)));
typedef int i32x4 __attribute__((ext_vector_type(4)));

constexpr int DM = 1024, NB = 8, SEQ = 4096, CTXL = 256;
constexpr int NLAT = NB * SEQ;
constexpr int NCTX = NB * CTXL;
constexpr int NT = NLAT + NCTX;
constexpr int RET_H = 4, RET_DK = 256, RET_DV = 512, RET_VW = 2048, RET_IN = 8192;
constexpr int MLA_H = 8, MLA_NOPE = 128, MLA_ROPE = 64, MLA_QK = 192, MLA_V = 128, MLA_QR = 384, MLA_KVR = 256, MLA_IN = 704, MLA_INP = 768;
constexpr int SKV = SEQ + CTXL;
constexpr int NE = 64, TOPK = 8, EFF = 256;
constexpr float EPS = 1e-6f;
constexpr int NWAVES = 8, NTHR = 512;

constexpr size_t MiB = 1u << 20;
constexpr size_t WS_CTL = 0, CTL_ZERO_BYTES = 1 * MiB;
constexpr size_t WS_MOD = 1 * MiB;
constexpr size_t WS_TABR = 1 * MiB + 512 * 1024;
constexpr size_t WS_TABM = WS_TABR + 64 * 64 * 8;
constexpr size_t WS_W_RI8 = 2 * MiB, WS_CS_RI = 10 * MiB;
constexpr size_t WS_W_RO8 = 11 * MiB, WS_CS_RO = 13 * MiB;
constexpr size_t WS_W_MI8 = 14 * MiB, WS_CS_MI = 15 * MiB;
constexpr size_t WS_W_QB = 16 * MiB;
constexpr size_t WS_W_KVB = 18 * MiB;
constexpr size_t WS_W_MO = 19 * MiB;
constexpr size_t WS_W_RT = 21 * MiB;
constexpr size_t WS_W_SGU8 = 22 * MiB, WS_CS_SGU = 23 * MiB;
constexpr size_t WS_W_SD = 24 * MiB;
constexpr size_t WS_W_EGU8 = 26 * MiB, WS_CS_EGU = 58 * MiB;
constexpr size_t WS_W_ED = 59 * MiB;
constexpr size_t WS_H8 = 92 * MiB, WS_HS = 126 * MiB;
constexpr size_t WS_OS = 127 * MiB;
constexpr size_t WS_H = 130 * MiB;
constexpr size_t WS_R = 198 * MiB;
constexpr size_t WS_XC = 1014 * MiB;
constexpr size_t WS_END = 1022 * MiB;
constexpr size_t WS_QK = WS_R, WS_V = WS_R + 136 * MiB, WS_G = WS_R + 272 * MiB, WS_YF = WS_R + 544 * MiB, WS_YB = WS_R + 680 * MiB;
constexpr size_t WS_O = WS_QK;
constexpr int MOE_ROWS = 294912 + NT;
constexpr size_t WS_RT_P = WS_R;
constexpr size_t WS_LISTW = WS_R + 2 * MiB;
constexpr size_t WS_ACT = WS_R + 11 * MiB;
constexpr size_t WS_YS = WS_R + 172 * MiB;
constexpr size_t WS_LOGIT = WS_YS;
constexpr size_t WS_LIST = WS_YS + 16 * MiB;
constexpr size_t WS_LISTS = WS_YS + 330 * MiB;
constexpr size_t WS_DEST = WS_LISTS + 10 * MiB;
static_assert((size_t)MOE_ROWS * 1024 <= 330 * MiB && ((size_t)NT * 9 + 1) * 1024 <= 330 * MiB && WS_LISTS + (size_t)64 * NT * 4 <= WS_DEST && WS_DEST + (size_t)64 * NT * 4 <= WS_XC, "ws map");
static_assert(WS_ACT + (size_t)MOE_ROWS * 512 <= WS_YS && WS_YS + (size_t)MOE_ROWS * 2048 <= WS_XC, "ws map");
constexpr size_t WS_A = WS_R;
constexpr size_t WS_AQN = WS_R + 52 * MiB;
constexpr size_t WS_AKVN = WS_R + 76 * MiB;
constexpr size_t WS_KROPE = WS_R + 93 * MiB;
constexpr size_t WS_QRAW = WS_R + 98 * MiB;
constexpr size_t WS_KVRAW = WS_R + 194 * MiB;
constexpr size_t WS_QF = WS_R + 330 * MiB;
constexpr size_t WS_KF = WS_R + 426 * MiB;
constexpr size_t WS_VF = WS_R + 528 * MiB;
constexpr size_t WS_OATT = WS_R + 596 * MiB;
constexpr size_t WS_XB = WS_R + 700 * MiB;
static_assert(WS_OATT + (size_t)NLAT * 1024 * 2 <= WS_XB && WS_DEST + (size_t)64 * NT * 4 <= WS_XB && WS_XB + (size_t)NT * 1024 * 2 <= WS_XC, "ws map");
constexpr int CW_BAR = 4096;
constexpr int CW_CNT = 8192;
constexpr int RING_BYTES = 131072, LDSCTL_OFF = RING_BYTES, LDS_BYTES = 147456;

__device__ __forceinline__ unsigned cvt_pk_bf16(float lo, float hi) { unsigned r; asm volatile("v_cvt_pk_bf16_f32 %0, %1, %2" : "=v"(r) : "v"(lo), "v"(hi)); return r; }
__device__ __forceinline__ float bf2f(bf16_t b) { return __uint_as_float(((unsigned)b) << 16); }
__device__ __forceinline__ float bflo(unsigned w) { return __uint_as_float(w << 16); }
__device__ __forceinline__ float bfhi(unsigned w) { return __uint_as_float(w & 0xffff0000u); }
__device__ __forceinline__ float wave_sum(float v) {
#pragma unroll
    for (int o = 1; o < 64; o <<= 1) v += __shfl_xor(v, o);
    return v;
}
__device__ __forceinline__ float siluf(float x) { return x * __builtin_amdgcn_rcpf(1.f + __builtin_amdgcn_exp2f(-1.4426950408889634f * x)); }
#define LDS_WAIT() asm volatile("s_waitcnt lgkmcnt(0)" ::: "memory")
#define VM_WAIT() asm volatile("s_waitcnt vmcnt(0)" ::: "memory")

#define XB_TMO      128
#define XB_XCNT(j)  (256  + 64 * (j))
#define XB_XSUB(j)  (1280 + 64 * (j))
#define XB_XGEN(j)  (2304 + 64 * (j))
#define XB_TOP      3328
#define XB_TOPGEN   3392
#define XCD_BAR_WORDS 3456
#define XB_SPIN_CAP (1u << 22)
__device__ __forceinline__ unsigned xb_ld(unsigned* p)              { return __hip_atomic_load(p, __ATOMIC_RELAXED, __HIP_MEMORY_SCOPE_AGENT); }
__device__ __forceinline__ unsigned xb_add(unsigned* p, unsigned v) { return __hip_atomic_fetch_add(p, v, __ATOMIC_RELAXED, __HIP_MEMORY_SCOPE_AGENT); }
__device__ __forceinline__ unsigned xb_xcc_id() { return (unsigned)__builtin_amdgcn_s_getreg((3 << 11) | 20) & 0xFu; }
#define XB_SPIN(cond, bar) do { unsigned _sp = 0; while (cond) { __builtin_amdgcn_s_sleep(1); \
    if ((++_sp & 255u) == 0u) { if (xb_ld(&(bar)[XB_TMO])) break; if (_sp > XB_SPIN_CAP) { atomicAdd(&(bar)[XB_TMO], 1u); break; } } } } while (0)
struct XcdBarrier { unsigned* bar; unsigned x; volatile LAS unsigned* st; };
__device__ __forceinline__ XcdBarrier xcd_barrier_post(unsigned* bar, volatile LAS unsigned* st) {
    XcdBarrier b; b.bar = bar; b.x = xb_xcc_id(); b.st = st;
    if (threadIdx.x == 0) (void)xb_add(&bar[XB_XCNT(b.x)], 1u);
    return b;
}
__device__ __forceinline__ void xcd_barrier_complete(unsigned* bar, unsigned x, unsigned& nloc, unsigned& nx) {
    const unsigned G = gridDim.x * gridDim.y * gridDim.z;
    unsigned sum, cnt, mine, sp = 0u;
    for (;;) {
        sum = 0u; cnt = 0u; mine = 0u;
#pragma unroll
        for (unsigned j = 0; j < 16; ++j) { const unsigned c = xb_ld(&bar[XB_XCNT(j)]); sum += c; cnt += (c > 0u) ? 1u : 0u; mine = (j == x) ? c : mine; }
        if (sum == G) break;
        __builtin_amdgcn_s_sleep(1);
        if ((++sp & 255u) == 0u) { if (xb_ld(&bar[XB_TMO])) break; if (sp > XB_SPIN_CAP) { atomicAdd(&bar[XB_TMO], 1u); break; } }
    }
    nloc = mine > 0u ? mine : 1u; nx = cnt > 0u ? cnt : 1u;
}
__device__ __forceinline__ void xcd_barrier(const XcdBarrier& b) {
    asm volatile("s_waitcnt vmcnt(0)" ::: "memory");
    __syncthreads();
    if (threadIdx.x == 0) {
        unsigned* bar = b.bar;
        __builtin_amdgcn_s_waitcnt(0);
        unsigned nloc = b.st[0], nx = b.st[1];
        if (nloc == 0u) { xcd_barrier_complete(bar, b.x, nloc, nx); b.st[0] = nloc; b.st[1] = nx; }
        const unsigned old = xb_add(&bar[XB_XSUB(b.x)], 1u);
        const unsigned gen = old / nloc;
        if (old + 1u == (gen + 1u) * nloc) {
            __builtin_amdgcn_fence(__ATOMIC_RELEASE, "agent");
            asm volatile("s_waitcnt vmcnt(0)" ::: "memory");
            const unsigned og = xb_add(&bar[XB_TOP], 1u);
            const unsigned tg = og / nx;
            if (og + 1u == (tg + 1u) * nx) xb_add(&bar[XB_TOPGEN], 1u);
            else XB_SPIN(xb_ld(&bar[XB_TOPGEN]) == tg, bar);
            __builtin_amdgcn_fence(__ATOMIC_ACQUIRE, "agent");
            xb_add(&bar[XB_XGEN(b.x)], 1u);
            asm volatile("s_waitcnt vmcnt(0)" ::: "memory");
        } else {
            XB_SPIN(xb_ld(&bar[XB_XGEN(b.x)]) == gen, bar);
            __builtin_amdgcn_fence(__ATOMIC_ACQUIRE, "agent");
            asm volatile("s_waitcnt vmcnt(0)" ::: "memory");
        }
    }
    __syncthreads();
}

namespace g8 {
constexpr int BM = 256, BK = 64, HALF = 128, HTB = HALF * BK * 2, STAGE_BYTES = 8 * HTB;
__host__ __device__ __forceinline__ int lds_byte(int r, int c) { const int st = (r >> 4) * 2 + (c >> 5), rr = r & 15, cc = c & 31, ob = rr * 64 + cc * 2; return st * 1024 + (ob ^ (((ob >> 9) & 1) << 5)); }
__host__ __device__ __forceinline__ void stage_rc(int b, int& R, int& C) { const int st = b / 1024, sb = b % 1024, swz = sb ^ (((sb >> 9) & 1) << 5); R = (st >> 1) * 16 + swz / 64; C = (st & 1) * 32 + (swz % 64) / 2; }
__host__ __device__ __forceinline__ int perm32(int rho) { const int n = rho >> 4, i = rho & 15; return 8 * (i >> 2) + 4 * n + (i & 3); }

struct Unit {
    const char* A;
    const char* B;
    const int* list;
    int row0, col0;
    int nvalid;
    int rbase;
    int aux;
    const float* rsl;
    const float* cs;
};

template <class E> struct epi_nst { static constexpr int value = 0; };
template <int N> __device__ __forceinline__ void g8_wait_v() { asm volatile("s_waitcnt vmcnt(%0)" :: "n"(N) : "memory"); }
template <bool I8, class Epi, class Sched>
__device__ __forceinline__ void gemm_phase(LAS unsigned char* lds, const int K_in, const int lda, const int ldb, const Sched& S, const Epi& E) {
    int K = K_in; asm volatile("" : "+s"(K));
    const int tid = threadIdx.x, wid = __builtin_amdgcn_readfirstlane(tid >> 6), lane = tid & 63, wr = wid >> 2, wc = wid & 3, fr = lane & 15, fq = lane >> 4;
    const int nt = K / BK;
    int Rst[2], Cst[2]; unsigned voffB[2];
#pragma unroll
    for (int i = 0; i < 2; ++i) { int R, C; stage_rc(tid * 16 + i * 8192, R, C); Rst[i] = R; Cst[i] = C; const int Rb = Epi::PERM == 2 ? (64 * (R >> 5) + 16 * ((R >> 2) & 3) + 4 * ((R >> 4) & 1) + (R & 3)) : Epi::PERM == 1 ? ((R & ~31) + perm32(R & 31)) : R; voffB[i] = (unsigned)(Rb * ldb + C) * 2u; }
    const size_t kstep = (size_t)(BK * 2);
    const size_t hstepB = (size_t)(Epi::PERM == 2 ? 8 : HALF) * ldb * 2;
    const unsigned ldsw = (unsigned)wid * 1024u;
    const int aoff = lds_byte(wr * 64 + fr, fq * 8), boff = lds_byte(wc * 32 + fr, fq * 8);
#define G8_SA(b, h) (((b) * 2 + (h)) * HTB)
#define G8_SB(b, h) ((4 + (b) * 2 + (h)) * HTB)
#define G8_STAGE(bufoff, gbase, voff) do { _Pragma("unroll") for (int _i = 0; _i < 2; ++_i) { unsigned _o = (voff)[_i]; asm volatile("" : "+v"(_o));     \
        __builtin_amdgcn_global_load_lds((const unsigned*)((const char*)(gbase) + _o), (LAS unsigned*)(lds + (bufoff) + ldsw + _i * 8192), 16, 0, 0); } } while (0)
#define G8_LDA(dst, b, h) do { _Pragma("unroll") for (int m = 0; m < 4; ++m) _Pragma("unroll") for (int k = 0; k < 2; ++k) dst[m][k] = *(const LAS bf16x8*)(lds + G8_SA(b, h) + aoff + m * 2048 + k * 1024); } while (0)
#define G8_LDB(dst, b, h) do { _Pragma("unroll") for (int n = 0; n < 2; ++n) _Pragma("unroll") for (int k = 0; k < 2; ++k) dst[n][k] = *(const LAS bf16x8*)(lds + G8_SB(b, h) + boff + n * 2048 + k * 1024); } while (0)
#define G8_MMA(ai, bj, At, Bt) do { __builtin_amdgcn_s_setprio(1); _Pragma("unroll") for (int m = 0; m < 4; ++m) _Pragma("unroll") for (int n = 0; n < 2; ++n) _Pragma("unroll") for (int k = 0; k < 2; ++k) { \
        if constexpr (I8) acc[ai][bj][m][n] = __builtin_bit_cast(f32x4, __builtin_amdgcn_mfma_i32_16x16x64_i8(__builtin_bit_cast(i32x4, Bt[n][k]), __builtin_bit_cast(i32x4, At[m][k]), __builtin_bit_cast(i32x4, acc[ai][bj][m][n]), 0, 0, 0)); \
        else acc[ai][bj][m][n] = __builtin_amdgcn_mfma_f32_16x16x32_bf16(Bt[n][k], At[m][k], acc[ai][bj][m][n], 0, 0, 0); } __builtin_amdgcn_s_setprio(0); } while (0)
#define G8_MMAZ(ai, bj, At, Bt) do { __builtin_amdgcn_s_setprio(1); _Pragma("unroll") for (int m = 0; m < 4; ++m) _Pragma("unroll") for (int n = 0; n < 2; ++n) { \
        if constexpr (I8) { acc[ai][bj][m][n] = __builtin_bit_cast(f32x4, __builtin_amdgcn_mfma_i32_16x16x64_i8(__builtin_bit_cast(i32x4, Bt[n][0]), __builtin_bit_cast(i32x4, At[m][0]), (i32x4){0, 0, 0, 0}, 0, 0, 0)); \
            acc[ai][bj][m][n] = __builtin_bit_cast(f32x4, __builtin_amdgcn_mfma_i32_16x16x64_i8(__builtin_bit_cast(i32x4, Bt[n][1]), __builtin_bit_cast(i32x4, At[m][1]), __builtin_bit_cast(i32x4, acc[ai][bj][m][n]), 0, 0, 0)); } \
        else { acc[ai][bj][m][n] = __builtin_amdgcn_mfma_f32_16x16x32_bf16(Bt[n][0], At[m][0], (f32x4){0.f, 0.f, 0.f, 0.f}, 0, 0, 0); \
            acc[ai][bj][m][n] = __builtin_amdgcn_mfma_f32_16x16x32_bf16(Bt[n][1], At[m][1], acc[ai][bj][m][n], 0, 0, 0); } } __builtin_amdgcn_s_setprio(0); } while (0)
#define G8_WAIT_V(n) asm volatile("s_waitcnt vmcnt(" #n ")" ::: "memory")
#define G8_WAIT_L(n) asm volatile("s_waitcnt lgkmcnt(" #n ")" ::: "memory")
#define G8_BAR __builtin_amdgcn_s_barrier()
#define G8_SCHED __builtin_amdgcn_sched_barrier(0)
#define G8_AOFF(u, dst) do { _Pragma("unroll") for (int _h = 0; _h < 2; ++_h) _Pragma("unroll") for (int _i = 0; _i < 2; ++_i) { \
        int _r = Rst[_i] + HALF * _h; if (Sched::GATHER) { _r = (u).list ? ((_r < (u).nvalid) ? (u).list[_r] : 0) : (u).rbase + _r; } \
        dst[_h][_i] = (unsigned)(_r * lda + Cst[_i]) * 2u; } } while (0)
    constexpr bool AUX = I8 && Sched::GATHER;
    LAS unsigned char* const side = lds + (LDSCTL_OFF + 4096);
#define G8_AUX(u, par) do { LAS unsigned char* _sb = side + (par) * 3072; \
        if (wid < 4) { if (Sched::GATHER && (u).list) __builtin_amdgcn_global_load_lds((const unsigned*)((u).list + 64 * wid + lane), (LAS unsigned*)(_sb + wid * 256), 4, 0, 0); \
            __builtin_amdgcn_global_load_lds((const unsigned*)((u).cs + 64 * wid + lane), (LAS unsigned*)(_sb + 2048 + wid * 256), 4, 0, 0); } \
        else __builtin_amdgcn_global_load_lds((const unsigned*)((u).rsl + 64 * (wid - 4) + lane), (LAS unsigned*)(_sb + 1024 + (wid - 4) * 256), 4, 0, 0); } while (0)
#define G8_AOFF_L(u, par, dst) do { const LAS int* _sl = (const LAS int*)(side + (par) * 3072); _Pragma("unroll") for (int _h = 0; _h < 2; ++_h) _Pragma("unroll") for (int _i = 0; _i < 2; ++_i) { \
        int _r = Rst[_i] + HALF * _h; if (Sched::GATHER) { _r = (u).list ? ((_r < (u).nvalid) ? _sl[_r] : 0) : (u).rbase + _r; } \
        dst[_h][_i] = (unsigned)(_r * lda + Cst[_i]) * 2u; } } while (0)
    Unit cur, nxt; int ui = 0;
    if (!S.next(0, cur)) return;
    constexpr bool ZC = !(I8 && Sched::GATHER);
    f32x4 acc[2][2][4][2];
#pragma unroll
    for (int a = 0; a < 2; ++a)
#pragma unroll
        for (int b = 0; b < 2; ++b)
#pragma unroll
            for (int m = 0; m < 4; ++m)
#pragma unroll
                for (int n = 0; n < 2; ++n) acc[a][b][m][n] = (f32x4){0.f, 0.f, 0.f, 0.f};
    bf16x8 At[4][2], B0[2][2], B1[2][2];
    unsigned ao[2][2], an[2][2];
    if constexpr (AUX) { G8_AUX(cur, 0); G8_WAIT_V(0); G8_BAR; G8_AOFF_L(cur, 0, ao); } else { G8_AOFF(cur, ao); }
    const char* cA = cur.A; const char* cB = cur.B;
    G8_STAGE(G8_SB(0, 0), cB, voffB); G8_STAGE(G8_SB(0, 1), cB + hstepB, voffB); G8_STAGE(G8_SA(0, 0), cA, ao[0]); G8_STAGE(G8_SA(0, 1), cA, ao[1]);
    if (wr == 1) G8_BAR;
    G8_WAIT_V(2); G8_BAR;
    G8_STAGE(G8_SB(1, 0), cB + kstep, voffB); G8_STAGE(G8_SA(1, 0), cA + kstep, ao[0]); G8_STAGE(G8_SB(1, 1), cB + hstepB + kstep, voffB);
    G8_WAIT_V(6); G8_BAR;
    for (;;) {
        const bool has_next = S.next(ui + 1, nxt);
        const char* nA = has_next ? nxt.A : cA; const char* nB = has_next ? nxt.B : cB;
        if constexpr (Sched::GATHER && !AUX) { if (has_next) { G8_AOFF(nxt, an); } }
        if (!Sched::GATHER || !has_next) {
#pragma unroll
            for (int h = 0; h < 2; ++h)
#pragma unroll
                for (int i = 0; i < 2; ++i) an[h][i] = ao[h][i]; }
        for (int t = 0; t < nt; t += 2) {
            const bool last = (t == nt - 2);
            if constexpr (AUX && Sched::GATHER) { if (last && has_next) { G8_AOFF_L(nxt, (ui + 1) & 1, an); } }
            const char* a1 = cA + (size_t)(t + 1) * kstep;
            const char* a2 = last ? nA : cA + (size_t)(t + 2) * kstep; const char* b2 = last ? nB : cB + (size_t)(t + 2) * kstep;
            const char* a3 = a2 + kstep; const char* b3 = b2 + kstep;
            unsigned a2o[2][2];
#pragma unroll
            for (int h = 0; h < 2; ++h)
#pragma unroll
                for (int i = 0; i < 2; ++i) a2o[h][i] = (Sched::GATHER && last) ? an[h][i] : ao[h][i];
            constexpr int NST = epi_nst<Epi>::value; const bool relax = NST > 0 && t == 0 && ui > 0;
            G8_LDB(B0, 0, 0); G8_LDB(B1, 0, 1); G8_SCHED; G8_LDA(At, 0, 0); G8_STAGE(G8_SA(1, 1), a1, ao[1]);
            if (relax) g8_wait_v<NST + 2>(); else G8_WAIT_V(8); G8_WAIT_L(0); G8_BAR; if (ZC && t == 0) { G8_MMAZ(0, 0, At, B0); G8_MMAZ(0, 1, At, B1); } else { G8_MMA(0, 0, At, B0); G8_MMA(0, 1, At, B1); } G8_BAR; G8_SCHED;
            if constexpr (AUX) { if (t == 0 && has_next) { G8_AUX(nxt, (ui + 1) & 1); } }
            G8_LDA(At, 0, 1); G8_STAGE(G8_SB(0, 0), b2, voffB); G8_STAGE(G8_SB(0, 1), b2 + hstepB, voffB); G8_STAGE(G8_SA(0, 0), a2, a2o[0]);
            if (relax) g8_wait_v<NST + 8>(); else G8_WAIT_V(8); G8_WAIT_L(0); G8_BAR; if (ZC && t == 0) { G8_MMAZ(1, 0, At, B0); G8_MMAZ(1, 1, At, B1); } else { G8_MMA(1, 0, At, B0); G8_MMA(1, 1, At, B1); } G8_BAR; G8_SCHED;
            G8_LDB(B0, 1, 0); G8_LDB(B1, 1, 1); G8_SCHED; G8_LDA(At, 1, 0); G8_STAGE(G8_SA(0, 1), a2, a2o[1]);
            if (relax) g8_wait_v<NST + 10>(); else G8_WAIT_V(8); G8_WAIT_L(0); G8_BAR; G8_MMA(0, 0, At, B0); G8_MMA(0, 1, At, B1); G8_BAR; G8_SCHED;
            G8_LDA(At, 1, 1); G8_STAGE(G8_SB(1, 0), b3, voffB); G8_STAGE(G8_SB(1, 1), b3 + hstepB, voffB); G8_STAGE(G8_SA(1, 0), a3, a2o[0]);
            G8_WAIT_V(8); G8_WAIT_L(0); G8_BAR; G8_MMA(1, 0, At, B0); G8_MMA(1, 1, At, B1); G8_BAR; G8_SCHED;
        }
        if (wr == 0) G8_BAR;
        if constexpr (I8) {
            const LAS unsigned char* sb = side + (ui & 1) * 3072;
            f32x4 csv[2][2];
#pragma unroll
            for (int bj = 0; bj < 2; ++bj)
#pragma unroll
                for (int n = 0; n < 2; ++n) { const int cidx = (Epi::PERM == 2 ? 64 * wc + 16 * fq + 8 * bj + 4 * n : bj * 128 + wc * 32 + (Epi::PERM == 1 ? 8 * fq + 4 * n : 16 * n + 4 * fq));
                    if constexpr (AUX) csv[bj][n] = *(const LAS f32x4*)(sb + 2048 + 4 * cidx); else csv[bj][n] = *(const f32x4*)(cur.cs + cidx); }
#pragma unroll
            for (int ai = 0; ai < 2; ++ai)
#pragma unroll
                for (int m = 0; m < 4; ++m) {
                    const int r = ai * 128 + wr * 64 + m * 16 + fr;
                    float rsv; if constexpr (AUX) rsv = *(const LAS float*)(sb + 1024 + 4 * r); else rsv = cur.rsl[r];
#pragma unroll
                    for (int bj = 0; bj < 2; ++bj)
#pragma unroll
                        for (int n = 0; n < 2; ++n) { const i32x4 iv = __builtin_bit_cast(i32x4, acc[ai][bj][m][n]);
                            acc[ai][bj][m][n] = (f32x4){(float)iv.x, (float)iv.y, (float)iv.z, (float)iv.w} * csv[bj][n] * rsv; }
                }
        }
        E(acc, cur, wr, wc, fr, fq);
        if (!has_next) break;
        if constexpr (!ZC) {
#pragma unroll
            for (int a = 0; a < 2; ++a)
#pragma unroll
                for (int b = 0; b < 2; ++b)
#pragma unroll
                    for (int m = 0; m < 4; ++m)
#pragma unroll
                        for (int n = 0; n < 2; ++n) acc[a][b][m][n] = (f32x4){0.f, 0.f, 0.f, 0.f};
        }
        cur = nxt; cA = nA; cB = nB; ++ui;
        if (wr == 1) G8_BAR;
#pragma unroll
        for (int h = 0; h < 2; ++h)
#pragma unroll
            for (int i = 0; i < 2; ++i) ao[h][i] = an[h][i];
    }
    G8_WAIT_V(0);
    G8_BAR;
#undef G8_SA
#undef G8_SB
#undef G8_STAGE
#undef G8_LDA
#undef G8_LDB
#undef G8_MMA
#undef G8_MMAZ
#undef G8_WAIT_V
#undef G8_WAIT_L
#undef G8_BAR
#undef G8_SCHED
#undef G8_AOFF
#undef G8_AOFF_L
#undef G8_AUX
}

struct DenseSched {
    static constexpr bool GATHER = false;
    const char* A; const char* B; int lda, ldb;
    const float* rs; const float* cs;
    int nM, nN, nwg, G, c;
    __device__ void init(const void* A_, int lda_, const void* B_, int ldb_, int M, int N, int G_, int c_, const float* rs_ = nullptr, const float* cs_ = nullptr) { A = (const char*)A_; B = (const char*)B_; lda = lda_; ldb = ldb_; nM = M / BM; nN = N / BM; nwg = nM * nN; G = G_; c = c_; rs = rs_; cs = cs_; }
    __device__ __forceinline__ bool next(int i, Unit& u) const {
        const int L = i * G + c; if (L >= nwg) return false;
        int wgid = L; { const int q = nwg / 8, r = nwg % 8, xcd = wgid % 8, off = wgid / 8; wgid = (xcd < r ? xcd * (q + 1) : r * (q + 1) + (xcd - r) * q) + off; }
        const int nig = 8 * nN, gid = wgid / nig, fm = gid * 8, gsz = (nM - fm) < 8 ? (nM - fm) : 8;
        const int pm = fm + ((wgid % nig) % gsz), pn = (wgid % nig) / gsz;
        u.A = A + (size_t)pm * BM * lda * 2; u.B = B + (size_t)pn * BM * ldb * 2; u.list = nullptr; u.row0 = pm * BM; u.col0 = pn * BM; u.nvalid = BM; u.rbase = pm * BM; u.aux = 0; u.rsl = rs + pm * BM; u.cs = cs + pn * BM; return true;
    }
};

template <bool GATH> struct GroupSched {
    static constexpr bool GATHER = GATH;
    const LAS int* tpre; const LAS int* cnts;
    const char* A; const char* B; const char* Bsh; const int* list; int lda, ldb, ncu; size_t bexp;
    const float* rs; const float* rsls; const float* cs; const float* cssh; int ncols;
    int G, c, total;
    __device__ __forceinline__ bool next(int i, Unit& u) const {
        const int L = i * G + c; if (L >= total) return false;
        const int tg = L / ncu, cu = L % ncu, lane = threadIdx.x & 63;
        const int t0 = tpre[lane], t1 = tpre[lane + 1];
        const unsigned long long m = __ballot(t0 <= tg && tg < t1);
        const int e = m ? __builtin_amdgcn_readfirstlane((int)__builtin_ctzll(m)) : 64;
        const int tile = tg - tpre[e], cn = cnts[e];
        u.nvalid = (cn - tile * 256) < 256 ? (cn - tile * 256) : 256;
        u.list = (e < 64 && list) ? list + (size_t)e * NT + tile * 256 : nullptr; u.rbase = tile * 256;
        u.A = GATH ? A : A + (size_t)tg * 256 * lda * 2;
        u.B = (e < 64 ? B + (size_t)e * bexp : Bsh) + (size_t)cu * 256 * ldb * 2;
        u.row0 = tg * 256; u.col0 = cu * 256; u.aux = e; u.rsl = e < 64 ? rsls + (size_t)e * NT + tile * 256 : rs + tile * 256; u.cs = (e < 64 ? cs + (size_t)e * ncols : cssh) + cu * 256; return true;
    }
};
}

struct Args { const void* in[26]; float* out; unsigned char* ws; int ph_lo, ph_hi; };
struct Frame {
    LAS unsigned char* lds;
    unsigned* ctl;
    unsigned char* ws;
    int tid, lane, wave, vcu, G;
};

__device__ __forceinline__ void conv_tile(const float* W, int K, int N, bf16_t* Bt, int n0, int k0, int kind, LAS unsigned char* T, int lane, const float* kscale) {
    const int g16 = lane & 15, kp = lane >> 4;
    int srcc, orow0, ostep = 1;
    if (kind == 1 && n0 < 2048) { const int hb = n0 & ~255, p0 = n0 & 255, a = p0 >> 7, i0 = (p0 & 127) >> 1, t = g16 >> 3; srcc = hb + 128 * a + 64 * t + i0 + (g16 & 7) * 4; orow0 = 8 * (g16 & 7) + t; ostep = 2; }
    else if (kind == 2) { const int u = n0 >> 8, cc = n0 & 255; srcc = (cc < 128 ? 128 * u + cc : 256 + 128 * u + (cc - 128)) + g16 * 4; orow0 = g16 * 4; }
    else { srcc = n0 + g16 * 4; orow0 = g16 * 4; }
    const bool valid = srcc < N;
    f32x4 v0[8], v1[8];
#pragma unroll
    for (int i = 0; i < 8; ++i) { const int k = k0 + 8 * i + 2 * kp;
        v0[i] = valid ? *(const f32x4*)(W + (size_t)k * N + srcc) : (f32x4){0.f, 0.f, 0.f, 0.f};
        v1[i] = valid ? *(const f32x4*)(W + (size_t)(k + 1) * N + srcc) : (f32x4){0.f, 0.f, 0.f, 0.f};
        if (kscale) { v0[i] = v0[i] * kscale[k]; v1[i] = v1[i] * kscale[k + 1]; } }
#pragma unroll
    for (int i = 0; i < 8; ++i) { const int kk = 8 * i + 2 * kp;
#pragma unroll
        for (int j = 0; j < 4; ++j) *(LAS unsigned*)(T + (orow0 + ostep * j) * 144 + kk * 2) = cvt_pk_bf16(v0[i][j], v1[i][j]); }
    LDS_WAIT(); asm volatile("" ::: "memory");
#pragma unroll
    for (int j = 0; j < 8; ++j) { const int n = 8 * j + (lane >> 3), c = lane & 7;
        const u32x4 o = *(const LAS u32x4*)(T + n * 144 + c * 16);
        *(u32x4*)(Bt + (size_t)(n0 + n) * K + k0 + 8 * c) = o; }
    LDS_WAIT(); asm volatile("" ::: "memory");
}
__device__ __forceinline__ void conv_job(Frame& F, int& base, const float* W, bf16_t* Bt, int K, int N, int nOut, int kind, int count, size_t wstride, size_t bstride, const float* kscale = nullptr) {
    LAS unsigned char* T = F.lds + F.wave * 16384;
    const int gw = F.vcu * NWAVES + F.wave, NGW = F.G * NWAVES;
    const int nnb = nOut / 64, per = nnb * (K / 64), tot = per * count;
    int it = gw - (base % NGW); if (it < 0) it += NGW;
    for (; it < tot; it += NGW) {
        const int mi = it / per, r = it % per, nb = r % nnb, kb = r / nnb;
        conv_tile(W + (size_t)mi * wstride, K, N, Bt + (size_t)mi * bstride, nb * 64, kb * 64, kind, T, F.lane, kscale);
    }
    base += tot;
}

template <int TPW, bool HOLD>
__device__ __forceinline__ void conv8_item(Frame& F, const float* W, int K, int N, signed char* B8, float* cs, int n0, int kind) {
    const int lane = F.lane, g16 = lane & 15, kp = lane >> 4;
    LAS float* cmax = (LAS float*)F.lds; LAS unsigned char* T = F.lds + 4096 + F.wave * 5120;
    int srcc, orow0, ostep = 1;
    if (kind == 1 && n0 < 2048) { const int hb = n0 & ~255, p0 = n0 & 255, a = p0 >> 7, i0 = (p0 & 127) >> 1, t = g16 >> 3; srcc = hb + 128 * a + 64 * t + i0 + (g16 & 7) * 4; orow0 = 8 * (g16 & 7) + t; ostep = 2; }
    else if (kind == 2) { const int u = n0 >> 8, cc = n0 & 255; srcc = (cc < 128 ? 128 * u + cc : 256 + 128 * u + (cc - 128)) + g16 * 4; orow0 = g16 * 4; }
    else { srcc = n0 + g16 * 4; orow0 = g16 * 4; }
    const bool valid = srcc < N;
    const float* wp = W + (size_t)(F.wave * TPW * 64 + 2 * kp) * N + (valid ? srcc : 0);
    f32x4 mx = (f32x4){0.f, 0.f, 0.f, 0.f};
#define C8_EMIT(x0, x1, tt) do { const int k0 = (F.wave * TPW + (tt)) * 64; \
        _Pragma("unroll") for (int i = 0; i < 8; ++i) { const int kk = 8 * i + 2 * kp; \
            _Pragma("unroll") for (int j = 0; j < 4; ++j) { const int q0 = (int)rintf(x0[i][j] * inv[j]), q1 = (int)rintf(x1[i][j] * inv[j]); \
                *(LAS unsigned short*)(T + (orow0 + ostep * j) * 80 + kk) = (unsigned short)((q0 & 255) | ((q1 & 255) << 8)); } } \
        LDS_WAIT(); asm volatile("" ::: "memory"); \
        _Pragma("unroll") for (int jj = 0; jj < 4; ++jj) { const int n = (lane >> 2) + 16 * jj, c = lane & 3; \
            *(u32x4*)(B8 + (size_t)(n0 + n) * K + k0 + 16 * c) = *(const LAS u32x4*)(T + n * 80 + c * 16); } \
        LDS_WAIT(); asm volatile("" ::: "memory"); } while (0)
#define C8_LOAD(x0, x1, tt) do { _Pragma("unroll") for (int i = 0; i < 8; ++i) { x0[i] = *(const f32x4*)(wp + (size_t)((tt) * 64 + 8 * i) * N); x1[i] = *(const f32x4*)(wp + (size_t)((tt) * 64 + 8 * i + 1) * N); } } while (0)
#define C8_MAX(x0, x1) do { _Pragma("unroll") for (int i = 0; i < 8; ++i) _Pragma("unroll") for (int j = 0; j < 4; ++j) mx[j] = fmaxf(mx[j], fmaxf(fabsf(x0[i][j]), fabsf(x1[i][j]))); } while (0)
#define C8_REDUCE() do { if (!valid) mx = (f32x4){0.f, 0.f, 0.f, 0.f}; \
        _Pragma("unroll") for (int j = 0; j < 4; ++j) { mx[j] = fmaxf(mx[j], __shfl_xor(mx[j], 16)); mx[j] = fmaxf(mx[j], __shfl_xor(mx[j], 32)); } \
        if (kp == 0) { _Pragma("unroll") for (int j = 0; j < 4; ++j) cmax[F.wave * 64 + orow0 + ostep * j] = mx[j]; } \
        __syncthreads(); \
        _Pragma("unroll") for (int j = 0; j < 4; ++j) { float m = 0.f; \
            _Pragma("unroll") for (int w = 0; w < 8; ++w) m = fmaxf(m, cmax[w * 64 + orow0 + ostep * j]); \
            const float sc = m > 0.f ? m * (1.f / 127.f) : 1.f; inv[j] = valid ? 1.f / sc : 0.f; \
            if (F.wave == 0 && kp == 0) cs[n0 + orow0 + ostep * j] = sc; } } while (0)
    f32x4 inv;
    if constexpr (HOLD && TPW == 2) {
        f32x4 xa0[8], xa1[8], xb0[8], xb1[8];
        C8_LOAD(xa0, xa1, 0); C8_LOAD(xb0, xb1, 1);
        C8_MAX(xa0, xa1); C8_MAX(xb0, xb1);
        C8_REDUCE();
        C8_EMIT(xa0, xa1, 0); C8_EMIT(xb0, xb1, 1);
    } else {
#pragma clang loop unroll(disable)
        for (int t = 0; t < TPW; ++t) { f32x4 x0[8], x1[8]; C8_LOAD(x0, x1, t); C8_MAX(x0, x1); }
        C8_REDUCE();
#pragma clang loop unroll(disable)
        for (int t = 0; t < TPW; ++t) { f32x4 x0[8], x1[8]; C8_LOAD(x0, x1, t); C8_EMIT(x0, x1, t); }
    }
    __syncthreads();
#undef C8_EMIT
#undef C8_LOAD
#undef C8_MAX
#undef C8_REDUCE
}
template <int TPW, bool HOLD>
__device__ __forceinline__ void conv8_job(Frame& F, int& base, const float* W, signed char* B8, float* cs, int K, int N, int nOut, int kind, int count, size_t wstride) {
    const int per = nOut / 64, tot = per * count;
    int it = F.vcu - (base % F.G); if (it < 0) it += F.G;
    for (; it < tot; it += F.G) { const int mi = it / per, nb = it % per;
        conv8_item<TPW, HOLD>(F, W + (size_t)mi * wstride, K, N, B8 + (size_t)mi * nOut * K, cs + (size_t)mi * nOut, nb * 64, kind); }
    base += tot;
}
__device__ __forceinline__ float wave_max(float v) {
#pragma unroll
    for (int o = 1; o < 64; o <<= 1) v = fmaxf(v, __shfl_xor(v, o));
    return v;
}
__device__ __forceinline__ unsigned pack_i8x4(float a, float b, float c, float d) { return ((unsigned)(int)rintf(a) & 255u) | (((unsigned)(int)rintf(b) & 255u) << 8) | (((unsigned)(int)rintf(c) & 255u) << 16) | ((unsigned)(int)rintf(d) << 24); }
__device__ __forceinline__ void quant_row_store(const f32x4 (&a)[4], signed char* h8row, float* hsp, int lane) {
    float m = 0.f;
#pragma unroll
    for (int j = 0; j < 4; ++j) m = fmaxf(m, fmaxf(fmaxf(fabsf(a[j].x), fabsf(a[j].y)), fmaxf(fabsf(a[j].z), fabsf(a[j].w))));
    m = wave_max(m);
    const float sc = m > 0.f ? m * (1.f / 127.f) : 1.f, inv = 1.f / sc;
#pragma unroll
    for (int j = 0; j < 4; ++j) *(unsigned*)(h8row + 4 * lane + 256 * j) = pack_i8x4(a[j].x * inv, a[j].y * inv, a[j].z * inv, a[j].w * inv);
    if (lane == 0) *hsp = sc;
}

__device__ __forceinline__ void mod_vectors(Frame& F, const float* c, const float* c_ctx, const float* ada_w, const float* ada_b, float* MOD) {
    LAS float* sc = (LAS float*)F.lds;
    LAS float* red = (LAS float*)(F.lds + 40960);
    bool loaded = false;
    for (int item = F.vcu; item < 96; item += F.G) {
        if (!loaded) { for (int i = F.tid; i < 9 * 1024; i += NTHR) { const float v = (i < 8192) ? c[i] : c_ctx[i - 8192]; sc[i] = siluf(v); } loaded = true; __syncthreads(); }
        const int layer = item / 48, cb = item % 48, col = cb * 128 + (F.tid & 127), kq = F.tid >> 7;
        const float* W = ada_w + (size_t)layer * 1024 * 6144 + col;
        float a[9];
#pragma unroll
        for (int r = 0; r < 9; ++r) a[r] = 0.f;
        for (int k = kq * 256; k < kq * 256 + 256; ++k) { const float w = W[(size_t)k * 6144];
#pragma unroll
            for (int r = 0; r < 9; ++r) a[r] += sc[r * 1024 + k] * w; }
#pragma unroll
        for (int r = 0; r < 9; ++r) red[(kq * 9 + r) * 128 + (F.tid & 127)] = a[r];
        __syncthreads();
        for (int i = F.tid; i < 9 * 128; i += NTHR) { const int r = i >> 7, cc = i & 127; const float v = red[(0 * 9 + r) * 128 + cc] + red[(1 * 9 + r) * 128 + cc] + red[(2 * 9 + r) * 128 + cc] + red[(3 * 9 + r) * 128 + cc];
            MOD[((size_t)layer * 9 + r) * 6144 + cb * 128 + cc] = v + ada_b[layer * 6144 + cb * 128 + cc]; }
        __syncthreads();
    }
}
__device__ __forceinline__ void rope_tables(Frame& F, f32x2* tabr, f32x2* tabm) {
    const int gt = F.vcu * NTHR + F.tid, NGT = F.G * NTHR;
    for (int i = gt; i < 64 * 64 + 64 * 16; i += NGT) {
        if (i < 4096) { const int pos = i >> 6, f = i & 63; const float inv = powf(10000.f, -(float)(2 * f) / 128.f); const float ang = (float)pos * inv; tabr[i] = (f32x2){cosf(ang), sinf(ang)}; }
        else { const int j = i - 4096, pos = j >> 4, f = j & 15; const float inv = powf(10000.f, -(float)(2 * f) / 32.f); const float ang = (float)pos * inv; tabm[j] = (f32x2){cosf(ang), sinf(ang)}; }
    }
}

__device__ __forceinline__ void norm_mod_row(const float* xrow, const float* g, const float* shift, const float* scale, bf16_t* orow, signed char* h8row, float* hsp, int lane) {
    const f32x4* xr = (const f32x4*)xrow + lane;
    f32x4 v[4]; float s = 0.f;
#pragma unroll
    for (int j = 0; j < 4; ++j) { v[j] = xr[64 * j]; s += (v[j].x * v[j].x + v[j].y * v[j].y) + (v[j].z * v[j].z + v[j].w * v[j].w); }
    const float rinv = rsqrtf(wave_sum(s) * (1.f / DM) + EPS);
#pragma unroll
    for (int j = 0; j < 4; ++j) {
        const f32x4 gg = ((const f32x4*)g)[lane + 64 * j], sh = ((const f32x4*)shift)[lane + 64 * j], sc = ((const f32x4*)scale)[lane + 64 * j];
        v[j].x = v[j].x * rinv * gg.x * (1.f + sc.x) + sh.x; v[j].y = v[j].y * rinv * gg.y * (1.f + sc.y) + sh.y;
        v[j].z = v[j].z * rinv * gg.z * (1.f + sc.z) + sh.z; v[j].w = v[j].w * rinv * gg.w * (1.f + sc.w) + sh.w;
        if (orow) ((unsigned long long*)orow)[lane + 64 * j] = (unsigned long long)cvt_pk_bf16(v[j].x, v[j].y) | ((unsigned long long)cvt_pk_bf16(v[j].z, v[j].w) << 32);
    }
    quant_row_store(v, h8row, hsp, lane);
}
__device__ __forceinline__ void norm_mod_row_b(const u32x4 (&xw)[2], const float* g, const float* shift, const float* scale, bf16_t* orow, signed char* h8row, float* hsp, int lane) {
    f32x4 v[4]; float s = 0.f;
#pragma unroll
    for (int j = 0; j < 2; ++j) { const u32x4 w = xw[j];
        v[2 * j] = (f32x4){bflo(w.x), bfhi(w.x), bflo(w.y), bfhi(w.y)}; v[2 * j + 1] = (f32x4){bflo(w.z), bfhi(w.z), bflo(w.w), bfhi(w.w)}; }
#pragma unroll
    for (int j = 0; j < 4; ++j) s += (v[j].x * v[j].x + v[j].y * v[j].y) + (v[j].z * v[j].z + v[j].w * v[j].w);
    const float rinv = rsqrtf(wave_sum(s) * (1.f / DM) + EPS);
    float m = 0.f;
#pragma unroll
    for (int j = 0; j < 4; ++j) { const int idx = 2 * (lane + 64 * (j >> 1)) + (j & 1);
        const f32x4 gg = ((const f32x4*)g)[idx], sh = ((const f32x4*)shift)[idx], sc = ((const f32x4*)scale)[idx];
        v[j] = v[j] * rinv * gg * (sc + 1.f) + sh;
        m = fmaxf(m, fmaxf(fmaxf(fabsf(v[j].x), fabsf(v[j].y)), fmaxf(fabsf(v[j].z), fabsf(v[j].w)))); }
#pragma unroll
    for (int j = 0; j < 2; ++j) { u32x4 w; w.x = cvt_pk_bf16(v[2 * j].x, v[2 * j].y); w.y = cvt_pk_bf16(v[2 * j].z, v[2 * j].w); w.z = cvt_pk_bf16(v[2 * j + 1].x, v[2 * j + 1].y); w.w = cvt_pk_bf16(v[2 * j + 1].z, v[2 * j + 1].w);
        ((u32x4*)orow)[lane + 64 * j] = w; }
    m = wave_max(m);
    const float qs = m > 0.f ? m * (1.f / 127.f) : 1.f, inv = 1.f / qs;
#pragma unroll
    for (int j = 0; j < 2; ++j) { u32x2 q; q.x = pack_i8x4(v[2 * j].x * inv, v[2 * j].y * inv, v[2 * j].z * inv, v[2 * j].w * inv); q.y = pack_i8x4(v[2 * j + 1].x * inv, v[2 * j + 1].y * inv, v[2 * j + 1].z * inv, v[2 * j + 1].w * inv);
        ((u32x2*)h8row)[lane + 64 * j] = q; }
    if (lane == 0) *hsp = qs;
}
__device__ __forceinline__ int mod_row_of(int r) { return r < NLAT ? (r >> 12) : 8; }

__device__ __forceinline__ void norm_router_block(Frame& F, int layer, int t0, int ntb, const bf16_t* XB, const float* g, const float* MODL, const bf16_t* Wr, signed char* H8, float* HS, float* LOGIT) {
    constexpr int HP = 2064;
    char* ldsg = (char*)F.lds;
    LAS unsigned char* HT = F.lds; LAS float* PT = (LAS float*)(F.lds + 36864);
    const int lane = F.lane, w = F.wave, l15 = lane & 15, q4 = lane >> 4;
    bf16x8 wreg[4][4];
#pragma unroll
    for (int nt = 0; nt < 4; ++nt)
#pragma unroll
        for (int ks = 0; ks < 4; ++ks) wreg[nt][ks] = *(const bf16x8*)(Wr + (size_t)(16 * nt + l15) * DM + 128 * w + 32 * ks + 8 * q4);
    for (int b0 = 0; b0 < ntb; b0 += 16) {
        u32x4 xw[2][2];
#pragma unroll
        for (int i = 0; i < 2; ++i) { const int rb = b0 + 2 * w + i; if (rb < ntb) { const bf16_t* xr = XB + (size_t)(t0 + rb) * DM; xw[i][0] = ((const u32x4*)xr)[lane]; xw[i][1] = ((const u32x4*)xr)[lane + 64]; } }
#pragma unroll
        for (int i = 0; i < 2; ++i) { const int rb = b0 + 2 * w + i; if (rb < ntb) { const int r = t0 + rb; const float* md = MODL + (size_t)mod_row_of(r) * 6144;
            norm_mod_row_b(xw[i], g, md + 3 * 1024, md + 4 * 1024, (bf16_t*)(ldsg + (2 * w + i) * HP), H8 + (size_t)r * DM, HS + r, lane); } }
        __syncthreads();
        f32x4 acc[4];
#pragma unroll
        for (int nt = 0; nt < 4; ++nt) acc[nt] = (f32x4){0.f, 0.f, 0.f, 0.f};
#pragma unroll
        for (int ks = 0; ks < 4; ++ks) { const bf16x8 hf = *(const LAS bf16x8*)(HT + l15 * HP + (128 * w + 32 * ks + 8 * q4) * 2);
#pragma unroll
            for (int nt = 0; nt < 4; ++nt) acc[nt] = __builtin_amdgcn_mfma_f32_16x16x32_bf16(wreg[nt][ks], hf, acc[nt], 0, 0, 0); }
#pragma unroll
        for (int nt = 0; nt < 4; ++nt) *(LAS f32x4*)(PT + (w * 16 + l15) * 64 + 16 * nt + 4 * q4) = acc[nt];
        __syncthreads();
        { const int row = F.tid >> 5, e2 = (F.tid & 31) * 2; f32x2 s = (f32x2){0.f, 0.f};
#pragma unroll
          for (int ww = 0; ww < 8; ++ww) { const f32x2 p = *(const LAS f32x2*)(PT + (ww * 16 + row) * 64 + e2); s.x += p.x; s.y += p.y; }
          if (b0 + row < ntb) *(f32x2*)(LOGIT + (size_t)(t0 + b0 + row) * 64 + e2) = s; }
    }
    __syncthreads();
}


struct EpiRetProj {
    static constexpr int PERM = 2;
    bf16_t* QK; bf16_t* V; bf16_t* Gt; const f32x4* tab;
    __device__ __forceinline__ void operator()(const f32x4 (&acc)[2][2][4][2], const g8::Unit& u, int wr, int wc, int fr, int fq) const {
        const int col0 = u.col0; bf16_t* base; int ldc, cc;
        if (col0 < 2048) { base = QK; ldc = 2048; cc = col0; } else if (col0 < 4096) { base = V; ldc = 2048; cc = col0 - 2048; } else { base = Gt; ldc = 4096; cc = col0 - 4096; }
        const bool isqk = col0 < 2048, rope = isqk && (u.row0 < NLAT);
        const float sc = (col0 >= 1024 && col0 < 2048) ? 0.0625f : 1.f;
        const int axis = wc >> 1, i0 = (64 * (wc & 1) + 16 * fq) >> 1;
#pragma unroll
        for (int ai = 0; ai < 2; ++ai)
#pragma unroll
            for (int m = 0; m < 4; ++m) {
                const int r = u.row0 + ai * 128 + wr * 64 + m * 16 + fr;
                bf16_t* rowp = base + (size_t)r * ldc + cc + wc * 64 + 16 * fq;
                const int s = r & 4095;
                u32x4 w[2];
#pragma unroll
                for (int bj = 0; bj < 2; ++bj) {
                    f32x4 v0 = acc[ai][bj][m][0], v1 = acc[ai][bj][m][1];
                    if (rope) {
                        const int pos = axis == 0 ? (s >> 6) : (s & 63);
                        const f32x4* tp = tab + ((pos * 64 + i0 + 4 * bj) >> 1);
                        const f32x4 t0 = tp[0], t1 = tp[1];
                        f32x4 o0, o1;
                        o0.x = v0.x * t0.x - v0.y * t0.y; o0.y = v0.y * t0.x + v0.x * t0.y; o0.z = v0.z * t0.z - v0.w * t0.w; o0.w = v0.w * t0.z + v0.z * t0.w;
                        o1.x = v1.x * t1.x - v1.y * t1.y; o1.y = v1.y * t1.x + v1.x * t1.y; o1.z = v1.z * t1.z - v1.w * t1.w; o1.w = v1.w * t1.z + v1.z * t1.w;
                        v0 = o0; v1 = o1;
                    }
                    v0 = v0 * sc; v1 = v1 * sc;
                    w[bj].x = cvt_pk_bf16(v0.x, v0.y); w[bj].y = cvt_pk_bf16(v0.z, v0.w); w[bj].z = cvt_pk_bf16(v1.x, v1.y); w[bj].w = cvt_pk_bf16(v1.z, v1.w);
                }
                if (col0 < 4096) { *(u32x4*)rowp = w[0]; *(u32x4*)(rowp + 8) = w[1]; }
                else {
                    u32x4 g8;
#pragma unroll
                    for (int bj = 0; bj < 2; ++bj)
#pragma unroll
                        for (int n = 0; n < 2; ++n) { f32x4 v = acc[ai][bj][m][n];
#pragma unroll
                            for (int j = 0; j < 4; ++j) v[j] = __builtin_amdgcn_fmed3f(v[j], -448.f, 448.f);
                            int p = 0; p = __builtin_amdgcn_cvt_pk_fp8_f32(v.x, v.y, p, false); p = __builtin_amdgcn_cvt_pk_fp8_f32(v.z, v.w, p, true); g8[bj * 2 + n] = (unsigned)p; }
                    *(u32x4*)((unsigned char*)Gt + (size_t)r * 4096 + cc + wc * 64 + 16 * fq) = g8;
                }
            }
    }
};
template <bool INBF> struct EpiResid {
    static constexpr int PERM = 1;
    const float* xin_l; const float* xin_c; bf16_t* xb; const float* gate;
    __device__ __forceinline__ void operator()(const f32x4 (&acc)[2][2][4][2], const g8::Unit& u, int wr, int wc, int fr, int fq) const {
        const bool lat = u.row0 < NLAT;
        const int cofs = u.col0 + wc * 32 + 8 * fq;
        const float* gin = gate + (size_t)(lat ? (u.row0 >> 12) : 8) * 6144 + cofs;
        f32x4 gv[2][2];
#pragma unroll
        for (int bj = 0; bj < 2; ++bj)
#pragma unroll
            for (int n = 0; n < 2; ++n) gv[bj][n] = *(const f32x4*)(gin + bj * 128 + n * 4);
#pragma unroll
        for (int ai = 0; ai < 2; ++ai)
#pragma unroll
            for (int m = 0; m < 4; ++m) {
                const int r = u.row0 + ai * 128 + wr * 64 + m * 16 + fr;
                bf16_t* op = xb + (size_t)r * DM + cofs;
                const float* ip = (lat ? xin_l + (size_t)r * DM : xin_c + (size_t)(r - NLAT) * DM) + cofs;
#pragma unroll
                for (int bj = 0; bj < 2; ++bj) {
                    f32x4 x0, x1;
                    if constexpr (INBF) { const u32x4 w = *(const u32x4*)(op + bj * 128); x0 = (f32x4){bflo(w.x), bfhi(w.x), bflo(w.y), bfhi(w.y)}; x1 = (f32x4){bflo(w.z), bfhi(w.z), bflo(w.w), bfhi(w.w)}; }
                    else { x0 = *(const f32x4*)(ip + bj * 128); x1 = *(const f32x4*)(ip + bj * 128 + 4); }
                    x0 += gv[bj][0] * acc[ai][bj][m][0]; x1 += gv[bj][1] * acc[ai][bj][m][1];
                    u32x4 w; w.x = cvt_pk_bf16(x0.x, x0.y); w.y = cvt_pk_bf16(x0.z, x0.w); w.z = cvt_pk_bf16(x1.x, x1.y); w.w = cvt_pk_bf16(x1.z, x1.w);
                    *(u32x4*)(op + bj * 128) = w; }
            }
    }
};

struct EpiLogits {
    static constexpr int PERM = 0;
    float* L;
    __device__ __forceinline__ void operator()(const f32x4 (&acc)[2][2][4][2], const g8::Unit& u, int wr, int wc, int fr, int fq) const {
        if (wc >= 2) return;
#pragma unroll
        for (int ai = 0; ai < 2; ++ai)
#pragma unroll
            for (int m = 0; m < 4; ++m) { float* rp = L + (size_t)(u.row0 + ai * 128 + wr * 64 + m * 16 + fr) * 64 + wc * 32 + 4 * fq;
#pragma unroll
                for (int n = 0; n < 2; ++n) *(f32x4*)(rp + n * 16) = acc[ai][0][m][n]; }
    }
};
struct EpiAct {
    static constexpr int PERM = 1;
    bf16_t* ACT;
    __device__ __forceinline__ void operator()(const f32x4 (&acc)[2][2][4][2], const g8::Unit& u, int wr, int wc, int fr, int fq) const {
#pragma unroll
        for (int ai = 0; ai < 2; ++ai)
#pragma unroll
            for (int m = 0; m < 4; ++m) {
                bf16_t* rp = ACT + (size_t)(u.row0 + ai * 128 + wr * 64 + m * 16 + fr) * 256 + (u.col0 >> 1) + wc * 32 + 8 * fq;
                const f32x4 g0 = acc[ai][0][m][0], g1 = acc[ai][0][m][1], u0 = acc[ai][1][m][0], u1 = acc[ai][1][m][1];
                u32x4 w; w.x = cvt_pk_bf16(siluf(g0.x) * u0.x, siluf(g0.y) * u0.y); w.y = cvt_pk_bf16(siluf(g0.z) * u0.z, siluf(g0.w) * u0.w);
                w.z = cvt_pk_bf16(siluf(g1.x) * u1.x, siluf(g1.y) * u1.y); w.w = cvt_pk_bf16(siluf(g1.z) * u1.z, siluf(g1.w) * u1.w);
                *(u32x4*)rp = w;
            }
    }
};
constexpr float YS_SCALE = 32.f;
struct EpiDown {
    static constexpr int PERM = 2;
    unsigned char* YS; const int* DEST;
    __device__ __forceinline__ void operator()(const f32x4 (&acc)[2][2][4][2], const g8::Unit& u, int wr, int wc, int fr, int fq) const {
        int drow[2][4];
#pragma unroll
        for (int ai = 0; ai < 2; ++ai)
#pragma unroll
            for (int m = 0; m < 4; ++m) { const int r = ai * 128 + wr * 64 + m * 16 + fr;
                if (u.aux < 64) drow[ai][m] = r < u.nvalid ? DEST[(size_t)u.aux * NT + u.rbase + r] : NT * 9;
                else drow[ai][m] = r < u.nvalid ? (u.rbase + r) * 9 + 8 : NT * 9; }
#pragma unroll
        for (int ai = 0; ai < 2; ++ai)
#pragma unroll
            for (int m = 0; m < 4; ++m) {
                const float wt = YS_SCALE;
                u32x4 w;
#pragma unroll
                for (int bj = 0; bj < 2; ++bj)
#pragma unroll
                    for (int n = 0; n < 2; ++n) { f32x4 v = acc[ai][bj][m][n] * wt;
#pragma unroll
                        for (int j = 0; j < 4; ++j) v[j] = __builtin_amdgcn_fmed3f(v[j], -448.f, 448.f);
                        int p = 0; p = __builtin_amdgcn_cvt_pk_fp8_f32(v.x, v.y, p, false); p = __builtin_amdgcn_cvt_pk_fp8_f32(v.z, v.w, p, true); w[bj * 2 + n] = (unsigned)p; }
                *(u32x4*)(YS + (size_t)drow[ai][m] * 1024 + u.col0 + wc * 64 + 16 * fq) = w;
            }
    }
};
namespace g8 { template <> struct epi_nst<EpiRetProj> { static constexpr int value = 8; }; template <bool B> struct epi_nst<EpiResid<B>> { static constexpr int value = 16; };
               template <> struct epi_nst<EpiAct> { static constexpr int value = 8; }; template <> struct epi_nst<EpiDown> { static constexpr int value = 8; }; }

constexpr int LDS_TPRE = LDSCTL_OFF + 1024, LDS_CNTS = LDSCTL_OFF + 2048;
__device__ __forceinline__ void build_tpre(Frame& F, int layer, int ntok) {
    LAS int* tpre = (LAS int*)(F.lds + LDS_TPRE); LAS int* cnts = (LAS int*)(F.lds + LDS_CNTS);
    __syncthreads();
    if (F.tid < 64) {
        const int cn = (int)__hip_atomic_load(F.ctl + CW_CNT + (layer * 64 + F.tid) * 16, __ATOMIC_RELAXED, __HIP_MEMORY_SCOPE_AGENT);
        int t = (cn + 255) >> 8, inc = t;
#pragma unroll
        for (int o = 1; o < 64; o <<= 1) { const int v = __shfl_up(inc, o); if (F.lane >= o) inc += v; }
        cnts[F.tid] = cn; tpre[F.tid + 1] = inc; if (F.tid == 0) tpre[0] = 0;
        if (F.tid == 63) { cnts[64] = ntok; tpre[65] = inc + (ntok >> 8); }
    }
    __syncthreads();
}
__device__ __forceinline__ void route_block(Frame& F, int layer, int t0, int ntb, const float* logits, const float* bias, int* LIST, float* RTW, int* DEST, const float* HS, float* LISTS) {
    LAS int* lcnt = (LAS int*)F.lds; LAS int* gbase = lcnt + 64; LAS int* rec_e = lcnt + 128; LAS float* rec_w = (LAS float*)(rec_e + 2048);
    const int lane = F.lane;
    if (F.tid < 64) lcnt[F.tid] = 0;
    __syncthreads();
    const float bl = bias[lane];
    for (int tl0 = F.wave; tl0 < ntb; tl0 += 4 * NWAVES) {
        constexpr int TT = 4;
        float s[TT], sel[TT], m1[TT], m2[TT], gs[TT], v[TT], ssum[TT]; int i1[TT], grank[TT], rank[TT]; bool ok[TT];
#pragma unroll
        for (int u = 0; u < TT; ++u) { const int tl = tl0 + u * NWAVES; ok[u] = tl < ntb; const int tq = ok[u] ? tl : tl0;
            s[u] = __builtin_amdgcn_rcpf(1.f + __expf(-logits[(size_t)(t0 + tq) * 64 + lane])); sel[u] = s[u] + bl; m1[u] = sel[u]; }
#pragma unroll
        for (int o = 1; o < 8; o <<= 1)
#pragma unroll
            for (int u = 0; u < TT; ++u) m1[u] = fmaxf(m1[u], __shfl_xor(m1[u], o));
#pragma unroll
        for (int u = 0; u < TT; ++u) i1[u] = (sel[u] == m1[u]) ? lane : 64;
#pragma unroll
        for (int o = 1; o < 8; o <<= 1)
#pragma unroll
            for (int u = 0; u < TT; ++u) i1[u] = min(i1[u], __shfl_xor(i1[u], o));
#pragma unroll
        for (int u = 0; u < TT; ++u) m2[u] = (lane == i1[u]) ? -INFINITY : sel[u];
#pragma unroll
        for (int o = 1; o < 8; o <<= 1)
#pragma unroll
            for (int u = 0; u < TT; ++u) m2[u] = fmaxf(m2[u], __shfl_xor(m2[u], o));
        const int g = lane >> 3;
#pragma unroll
        for (int u = 0; u < TT; ++u) { gs[u] = m1[u] + m2[u]; grank[u] = 0; }
#pragma unroll
        for (int gg = 0; gg < 8; ++gg)
#pragma unroll
            for (int u = 0; u < TT; ++u) { const float o = __builtin_bit_cast(float, __builtin_amdgcn_readlane(__builtin_bit_cast(int, gs[u]), gg * 8)); grank[u] += (o > gs[u] || (o == gs[u] && gg < g)) ? 1 : 0; }
#pragma unroll
        for (int u = 0; u < TT; ++u) { v[u] = grank[u] < 4 ? sel[u] : -INFINITY; rank[u] = 0; }
#pragma unroll
        for (int l = 0; l < 64; ++l)
#pragma unroll
            for (int u = 0; u < TT; ++u) { const float o = __builtin_bit_cast(float, __builtin_amdgcn_readlane(__builtin_bit_cast(int, v[u]), l)); rank[u] += (o > v[u] || (o == v[u] && l < lane)) ? 1 : 0; }
#pragma unroll
        for (int u = 0; u < TT; ++u) ssum[u] = (rank[u] < 8) ? s[u] : 0.f;
#pragma unroll
        for (int o = 1; o < 64; o <<= 1)
#pragma unroll
            for (int u = 0; u < TT; ++u) ssum[u] += __shfl_xor(ssum[u], o);
#pragma unroll
        for (int u = 0; u < TT; ++u) {
            if (ok[u] && rank[u] < 8) { const int tl = tl0 + u * NWAVES;
                const int lp = __hip_atomic_fetch_add(lcnt + lane, 1, __ATOMIC_RELAXED, __HIP_MEMORY_SCOPE_WORKGROUP);
                rec_e[tl * 8 + rank[u]] = (lane << 20) | lp; rec_w[tl * 8 + rank[u]] = s[u] / ssum[u] * 2.5f; }
        }
    }
    __syncthreads();
    if (F.tid < 64) gbase[F.tid] = (int)__hip_atomic_fetch_add(F.ctl + CW_CNT + (layer * 64 + F.tid) * 16, (unsigned)lcnt[F.tid], __ATOMIC_RELAXED, __HIP_MEMORY_SCOPE_AGENT);
    __syncthreads();
    for (int i = F.tid; i < ntb * 8; i += NTHR) {
        const int el = rec_e[i], e = el >> 20, p = gbase[e] + (el & 0xfffff), t = t0 + (i >> 3);
        LIST[(size_t)e * NT + p] = t; LISTS[(size_t)e * NT + p] = HS[t]; DEST[(size_t)e * NT + p] = t * 9 + (i & 7); RTW[(size_t)t * 8 + (i & 7)] = rec_w[i];
    }
    __syncthreads();
}
template <bool OUTF32> __device__ __forceinline__ void combine_row(Frame& F, const float* RTW, int t, const unsigned char* YS, const bf16_t* xrow, float* xof, bf16_t* xob, const float* gate, bool donorm, const float* g, const float* shift, const float* scale, signed char* h8row, float* hsp) {
    const int lane = F.lane;
    u32x4 yv[9];
#pragma unroll
    for (int k = 0; k < 9; ++k) yv[k] = *(const u32x4*)(YS + ((size_t)t * 9 + k) * 1024 + 16 * lane);
    f32x4 xi[4];
#pragma unroll
    for (int j = 0; j < 2; ++j) { const u32x4 w = ((const u32x4*)xrow)[2 * lane + j];
        xi[2 * j] = (f32x4){bflo(w.x), bfhi(w.x), bflo(w.y), bfhi(w.y)}; xi[2 * j + 1] = (f32x4){bflo(w.z), bfhi(w.z), bflo(w.w), bfhi(w.w)}; }
    f32x4 a[4];
#pragma unroll
    for (int j = 0; j < 4; ++j) a[j] = (f32x4){0.f, 0.f, 0.f, 0.f};
#pragma unroll
    for (int k = 0; k < 9; ++k) { const float wk = k < 8 ? RTW[(size_t)t * 8 + (k < 8 ? k : 0)] : 1.f;
#pragma unroll
        for (int j = 0; j < 4; ++j) { const f32x2 lo = __builtin_amdgcn_cvt_pk_f32_fp8((int)yv[k][j], false), hi = __builtin_amdgcn_cvt_pk_f32_fp8((int)yv[k][j], true);
            a[j].x += wk * lo.x; a[j].y += wk * lo.y; a[j].z += wk * hi.x; a[j].w += wk * hi.y; } }
    f32x4 v[4]; float ss = 0.f;
#pragma unroll
    for (int j = 0; j < 4; ++j) { const f32x4 gg = *(const f32x4*)(gate + 16 * lane + 4 * j);
        v[j] = xi[j] + gg * a[j] * (1.f / YS_SCALE);
        if constexpr (OUTF32) *(f32x4*)(xof + 16 * lane + 4 * j) = v[j];
        ss += (v[j].x * v[j].x + v[j].y * v[j].y) + (v[j].z * v[j].z + v[j].w * v[j].w); }
    if constexpr (!OUTF32) {
#pragma unroll
        for (int j = 0; j < 2; ++j) { u32x4 w; w.x = cvt_pk_bf16(v[2 * j].x, v[2 * j].y); w.y = cvt_pk_bf16(v[2 * j].z, v[2 * j].w); w.z = cvt_pk_bf16(v[2 * j + 1].x, v[2 * j + 1].y); w.w = cvt_pk_bf16(v[2 * j + 1].z, v[2 * j + 1].w);
            ((u32x4*)xob)[2 * lane + j] = w; }
    }
    if (donorm) {
        const float rinv = rsqrtf(wave_sum(ss) * (1.f / DM) + EPS);
        float m = 0.f;
#pragma unroll
        for (int j = 0; j < 4; ++j) {
            const f32x4 gg = *(const f32x4*)(g + 16 * lane + 4 * j), sh = *(const f32x4*)(shift + 16 * lane + 4 * j), sc = *(const f32x4*)(scale + 16 * lane + 4 * j);
            v[j] = v[j] * rinv * gg * (sc + 1.f) + sh;
            m = fmaxf(m, fmaxf(fmaxf(fabsf(v[j].x), fabsf(v[j].y)), fmaxf(fabsf(v[j].z), fabsf(v[j].w))));
        }
        m = wave_max(m);
        const float qs = m > 0.f ? m * (1.f / 127.f) : 1.f, inv = 1.f / qs;
        u32x4 q;
#pragma unroll
        for (int j = 0; j < 4; ++j) q[j] = pack_i8x4(v[j].x * inv, v[j].y * inv, v[j].z * inv, v[j].w * inv);
        *(u32x4*)(h8row + 16 * lane) = q;
        if (lane == 0) *hsp = qs;
    }
}

struct EpiStore {
    static constexpr int PERM = 1;
    bf16_t* O; int ldc;
    __device__ __forceinline__ void operator()(const f32x4 (&acc)[2][2][4][2], const g8::Unit& u, int wr, int wc, int fr, int fq) const {
#pragma unroll
        for (int ai = 0; ai < 2; ++ai)
#pragma unroll
            for (int m = 0; m < 4; ++m) {
                bf16_t* rp = O + (size_t)(u.row0 + ai * 128 + wr * 64 + m * 16 + fr) * ldc + u.col0 + wc * 32 + 8 * fq;
#pragma unroll
                for (int bj = 0; bj < 2; ++bj) { const f32x4 v0 = acc[ai][bj][m][0], v1 = acc[ai][bj][m][1];
                    u32x4 w; w.x = cvt_pk_bf16(v0.x, v0.y); w.y = cvt_pk_bf16(v0.z, v0.w); w.z = cvt_pk_bf16(v1.x, v1.y); w.w = cvt_pk_bf16(v1.z, v1.w);
                    *(u32x4*)(rp + bj * 128) = w; }
            }
    }
};

namespace g8 { template <> struct epi_nst<EpiStore> { static constexpr int value = 16; }; }

__device__ __forceinline__ void mla_final_row(int r, const bf16_t* A, const bf16_t* QRAW, const bf16_t* KVRAW, const float* qnorm, const float* knorm, const f32x2* tabm, signed char* QF, signed char* KF, bf16_t* VF, int lane) {
    const bool lat = r < NLAT;
    const int b = lat ? (r >> 12) : ((r - NLAT) >> 8), s = lat ? (r & 4095) : 0, kidx = lat ? s : 4096 + ((r - NLAT) & 255);
    constexpr float QKS = 127.f / 8.f;
    unsigned qw[8], kw[8], vw[8], aq[3]; bf16_t qrp[8];
    const bf16_t* kvr = KVRAW + (size_t)r * 2048; const bf16_t* ar = A + (size_t)r * 768;
#pragma unroll
    for (int h = 0; h < 8; ++h) { kw[h] = *(const unsigned*)(kvr + h * 256 + 2 * lane); vw[h] = *(const unsigned*)(kvr + h * 256 + 128 + 2 * lane); }
    const u32x2 akv = *(const u32x2*)(ar + 384 + 4 * lane); const float akr = bf2f(ar[640 + lane]);
    if (lat) {
        const bf16_t* qrw = QRAW + (size_t)r * 1536;
#pragma unroll
        for (int h = 0; h < 8; ++h) { qw[h] = *(const unsigned*)(qrw + h * 192 + 2 * lane); qrp[h] = qrw[h * 192 + 128 + lane]; }
#pragma unroll
        for (int j = 0; j < 3; ++j) aq[j] = *(const unsigned*)(ar + 128 * j + 2 * lane);
    }
    const f32x2 gq = *(const f32x2*)(qnorm + 2 * lane), gk = *(const f32x2*)(knorm + 2 * lane); const float gqr = qnorm[128 + lane], gkr = knorm[128 + lane];
    const int a = lane >> 5, t = (lane >> 4) & 1, i = lane & 15, pos = a == 0 ? (s >> 6) : (s & 63);
    const f32x2 cs = tabm[pos * 16 + i];
    float sk[8], sq[8], sr[8];
    float skv = bflo(akv.x) * bflo(akv.x) + bfhi(akv.x) * bfhi(akv.x) + bflo(akv.y) * bflo(akv.y) + bfhi(akv.y) * bfhi(akv.y), skr = akr * akr, saq = 0.f;
#pragma unroll
    for (int h = 0; h < 8; ++h) { const float k0 = bflo(kw[h]), k1 = bfhi(kw[h]); sk[h] = k0 * k0 + k1 * k1; }
    if (lat) {
#pragma unroll
        for (int h = 0; h < 8; ++h) { const float q0 = bflo(qw[h]), q1 = bfhi(qw[h]), qr_ = bf2f(qrp[h]); sq[h] = q0 * q0 + q1 * q1; sr[h] = qr_ * qr_; }
#pragma unroll
        for (int j = 0; j < 3; ++j) saq += bflo(aq[j]) * bflo(aq[j]) + bfhi(aq[j]) * bfhi(aq[j]);
    }
#pragma unroll
    for (int o = 1; o < 64; o <<= 1) {
#pragma unroll
        for (int h = 0; h < 8; ++h) sk[h] += __shfl_xor(sk[h], o);
        skv += __shfl_xor(skv, o); skr += __shfl_xor(skr, o);
        if (lat) {
#pragma unroll
            for (int h = 0; h < 8; ++h) { sq[h] += __shfl_xor(sq[h], o); sr[h] += __shfl_xor(sr[h], o); }
            saq += __shfl_xor(saq, o);
        }
    }
    const float rkv = rsqrtf(skv * (1.f / 256.f) + EPS), rkv2 = rkv * rkv;
    const float rqa = lat ? rsqrtf(saq * (1.f / 384.f) + EPS) : 1.f, rqa2 = rqa * rqa;
    float krn = akr * rsqrtf(skr * (1.f / 64.f) + EPS) * gkr;
    { const float pr = __shfl_xor(krn, 16); if (lat) krn = krn * cs.x + (t ? pr * cs.y : -pr * cs.y); }
    const int kr8 = (int)rintf(__builtin_amdgcn_fmed3f(krn * QKS, -127.f, 127.f));
#pragma unroll
    for (int h = 0; h < 8; ++h) {
        const size_t kvo = (size_t)(b * 8 + h) * SKV + kidx;
        const float rinv = rkv * rsqrtf(rkv2 * sk[h] * (1.f / 128.f) + EPS) * QKS;
        signed char* ko = KF + kvo * 192;
        { const int k0 = (int)rintf(__builtin_amdgcn_fmed3f(bflo(kw[h]) * rinv * gk.x, -127.f, 127.f)), k1 = (int)rintf(__builtin_amdgcn_fmed3f(bfhi(kw[h]) * rinv * gk.y, -127.f, 127.f));
          *(unsigned short*)(ko + 2 * lane) = (unsigned short)((k0 & 255) | ((k1 & 255) << 8)); }
        ko[128 + lane] = (signed char)kr8;
        *(unsigned*)(VF + kvo * 128 + 2 * lane) = cvt_pk_bf16(bflo(vw[h]) * rkv, bfhi(vw[h]) * rkv);
        if (lat) {
            const float rq = rqa * rsqrtf(rqa2 * sq[h] * (1.f / 128.f) + EPS) * QKS, rr = rqa * rsqrtf(rqa2 * sr[h] * (1.f / 64.f) + EPS);
            signed char* qo = QF + ((size_t)(b * 8 + h) * 4096 + s) * 192;
            { const int q0 = (int)rintf(__builtin_amdgcn_fmed3f(bflo(qw[h]) * rq * gq.x, -127.f, 127.f)), q1 = (int)rintf(__builtin_amdgcn_fmed3f(bfhi(qw[h]) * rq * gq.y, -127.f, 127.f));
              *(unsigned short*)(qo + 2 * lane) = (unsigned short)((q0 & 255) | ((q1 & 255) << 8)); }
            float vn = bf2f(qrp[h]) * rr * gqr; const float pr = __shfl_xor(vn, 16);
            vn = vn * cs.x + (t ? pr * cs.y : -pr * cs.y);
            qo[128 + lane] = (signed char)(int)rintf(__builtin_amdgcn_fmed3f(vn * QKS, -127.f, 127.f));
        }
    }
}

namespace att {
constexpr int NW = 8, QBLK = 32, KVBLK = 64, DQ = 192, DV = 128;
constexpr int KROW = 208;
constexpr int SHM_V = KVBLK * DV * 2, SHM_K = KVBLK * KROW;
constexpr int K_OFF = 3 * SHM_V, WS_OFF = K_OFF + 3 * SHM_K;
constexpr float THRL = 11.5f;
constexpr float SC = 0.07216878364870322f * 1.4426950408889634f / (15.875f * 15.875f);
constexpr float MAGIC = 12582912.f;
typedef int i32x16 __attribute__((ext_vector_type(16)));
#define SBAR() __builtin_amdgcn_sched_barrier(0)
#define MF8(A, B, C) __builtin_amdgcn_mfma_i32_32x32x32_i8((A), (B), (C), 0, 0, 0)
#define MFB(A, B, C) __builtin_amdgcn_mfma_f32_32x32x16_bf16((A), (B), (C), 0, 0, 0)
#define EX2(x) __builtin_amdgcn_exp2f(x)
__device__ __forceinline__ int crow(int r, int hi) { return (r & 3) + 8 * (r >> 2) + 4 * hi; }
__device__ __forceinline__ int v_st(int k, int c) { const int kk = (k & ~0xC) | ((k & 4) << 1) | ((k & 8) >> 1); return ((kk >> 3) * 4 + (c >> 5)) * 512 + ((kk & 7) * 32 + (c & 31)) * 2; }
__device__ __forceinline__ int v_rd_base(int lane) { return ((lane & 3) << 3) | (((lane >> 2) & 3) << 6) | (((lane >> 4) & 1) << 5) | (((lane >> 5) & 1) << 8); }
constexpr int v_rd_off(int d0, int ks, int half) { return d0 * 512 + ks * 4096 + half * 2048; }
typedef short v4i16_t __attribute__((ext_vector_type(4)));
__device__ __forceinline__ bf16x8 vfrag(const LAS unsigned char* p, int off) {
    const s16x4 l = __builtin_bit_cast(s16x4, __builtin_amdgcn_ds_read_tr16_b64_v4i16((LAS v4i16_t*)(p + off)));
    const s16x4 h = __builtin_bit_cast(s16x4, __builtin_amdgcn_ds_read_tr16_b64_v4i16((LAS v4i16_t*)(p + off + 2048)));
    return (bf16x8){l[0], l[1], l[2], l[3], h[0], h[1], h[2], h[3]};
}
#define EXP4(P, R) do { P[R] = EX2(P[R]); P[(R) + 1] = EX2(P[(R) + 1]); P[(R) + 2] = EX2(P[(R) + 2]); P[(R) + 3] = EX2(P[(R) + 3]); } while (0)
#define EXP3(P, R) do { P[R] = EX2(P[R]); P[(R) + 1] = EX2(P[(R) + 1]); P[(R) + 2] = EX2(P[(R) + 2]); } while (0)
#define ADD8(P, R) do { ps += P[R]; pt += P[(R) + 1]; ps += P[(R) + 2]; pt += P[(R) + 3]; ps += P[(R) + 4]; pt += P[(R) + 5]; ps += P[(R) + 6]; pt += P[(R) + 7]; } while (0)
#define MAX8(P, R) do { pm = fmaxf(fmaxf(pm, P[R]), P[(R) + 1]); pn = fmaxf(fmaxf(pn, P[(R) + 2]), P[(R) + 3]); pm = fmaxf(fmaxf(pm, P[(R) + 4]), P[(R) + 5]); pn = fmaxf(fmaxf(pn, P[(R) + 6]), P[(R) + 7]); } while (0)
#define FMA8(P, R) do { _Pragma("unroll") for (int _r = 0; _r < 8; ++_r) P[(R) + _r] = fmaf(P[(R) + _r], SC, mc); } while (0)
#define PK4(P, BASE, OUT) do { unsigned a0_ = cvt_pk_bf16(P[BASE + 0], P[BASE + 1]), a1_ = cvt_pk_bf16(P[BASE + 2], P[BASE + 3]);   \
    unsigned b0_ = cvt_pk_bf16(P[BASE + 4], P[BASE + 5]), b1_ = cvt_pk_bf16(P[BASE + 6], P[BASE + 7]);                              \
    auto r0_ = __builtin_amdgcn_permlane32_swap(a0_, b0_, false, false); auto r1_ = __builtin_amdgcn_permlane32_swap(a1_, b1_, false, false); \
    u32x4 w_ = {r0_[0], r1_[0], r0_[1], r1_[1]}; OUT = __builtin_bit_cast(bf16x8, w_); } while (0)
__device__ __forceinline__ void region1(f32x16& Y0, f32x16& Y1, f32x16& X0, f32x16& X1, float alX, float& l_reg, bf16x8& pa0, bf16x8& pa1, bf16x8& pa2, bf16x8& pa3,
                                        const char* kb, const i32x4* qr, const i32x16& mg) {
#define KF(i) (*reinterpret_cast<const i32x4*>(kb + ((i) & 1) * 32 * KROW + ((i) >> 1) * 32))
    i32x16 a0, a1; i32x4 f0 = KF(0), f1 = KF(1), f2 = KF(2);
    float ps = 0.f, pt = 0.f;
    EXP4(X1, 0); EXP4(X1, 4); SBAR();
    a0 = MF8(f0, qr[0], mg); f0 = KF(3); EXP4(X1, 8); SBAR();
    a1 = MF8(f1, qr[0], mg); f1 = KF(4); EXP4(X1, 12); SBAR();
    a0 = MF8(f2, qr[1], a0); f2 = KF(5); ADD8(X0, 0); SBAR();
    a1 = MF8(f0, qr[1], a1); f0 = KF(6); ADD8(X0, 8); SBAR();
    a0 = MF8(f1, qr[2], a0); f1 = KF(7); ADD8(X1, 0); SBAR();
    a1 = MF8(f2, qr[2], a1); f2 = KF(8); ADD8(X1, 8); SBAR();
    a0 = MF8(f0, qr[3], a0); f0 = KF(9);
    { ps += pt; auto rr = __builtin_amdgcn_permlane32_swap(__float_as_uint(ps), __float_as_uint(ps), false, false); ps = __uint_as_float(rr[0]) + __uint_as_float(rr[1]); l_reg = l_reg * alX + ps; }
    SBAR();
    a1 = MF8(f1, qr[3], a1); f1 = KF(10); PK4(X0, 0, pa0); SBAR();
    a0 = MF8(f2, qr[4], a0); f2 = KF(11); PK4(X0, 8, pa1); SBAR();
    a1 = MF8(f0, qr[4], a1); PK4(X1, 0, pa2); SBAR();
    a0 = MF8(f1, qr[5], a0); PK4(X1, 8, pa3); SBAR();
    a1 = MF8(f2, qr[5], a1); SBAR();
    Y0 = __builtin_bit_cast(f32x16, a0); Y1 = __builtin_bit_cast(f32x16, a1);
#undef KF
}
__device__ __forceinline__ void region2(f32x16* o, f32x16& Y0, f32x16& Y1, float& m_reg, float& alY, bf16x8 pa0, bf16x8 pa1, bf16x8 pa2, bf16x8 pa3, const LAS unsigned char* vp) {
#define VF(n) vfrag(vp, v_rd_off((((n) >> 3) << 1) | ((n) & 1), ((n) >> 1) & 3, 0))
    bf16x8 g0 = VF(0), g1 = VF(1), g2 = VF(2);
    float pm = Y0[0], pn = Y0[1], mc;
    SBAR();
    o[0] = MFB(pa0, g0, o[0]); g0 = VF(3); MAX8(Y0, 0); SBAR();
    o[1] = MFB(pa0, g1, o[1]); g1 = VF(4); MAX8(Y0, 8); SBAR();
    o[0] = MFB(pa1, g2, o[0]); g2 = VF(5); MAX8(Y1, 0); SBAR();
    o[1] = MFB(pa1, g0, o[1]); g0 = VF(6); MAX8(Y1, 8); SBAR();
    o[0] = MFB(pa2, g1, o[0]); g1 = VF(7);
    { pm = fmaxf(pm, pn); auto rr = __builtin_amdgcn_permlane32_swap(__float_as_uint(pm), __float_as_uint(pm), false, false); pm = fmaxf(__uint_as_float(rr[0]), __uint_as_float(rr[1])); pm = (pm - MAGIC) * SC; }
    SBAR();
    o[1] = MFB(pa2, g2, o[1]); g2 = VF(8);
    { const bool ok = __all(pm - m_reg <= THRL); const float mn = ok ? m_reg : fmaxf(m_reg, pm); alY = EX2(m_reg - mn); m_reg = mn; mc = -(mn + MAGIC * SC); }
    SBAR();
    o[0] = MFB(pa3, g0, o[0]); g0 = VF(9); FMA8(Y0, 0); SBAR();
    o[1] = MFB(pa3, g1, o[1]); g1 = VF(10); FMA8(Y0, 8); SBAR();
    o[2] = MFB(pa0, g2, o[2]); g2 = VF(11); FMA8(Y1, 0); SBAR();
    o[3] = MFB(pa0, g0, o[3]); g0 = VF(12); FMA8(Y1, 8); SBAR();
    o[2] = MFB(pa1, g1, o[2]); g1 = VF(13); EXP3(Y0, 0); SBAR();
    o[3] = MFB(pa1, g2, o[3]); g2 = VF(14); EXP3(Y0, 3); SBAR();
    o[2] = MFB(pa2, g0, o[2]); g0 = VF(15); EXP3(Y0, 6); SBAR();
    o[3] = MFB(pa2, g1, o[3]); EXP3(Y0, 9); SBAR();
    o[2] = MFB(pa3, g2, o[2]); EXP3(Y0, 12); SBAR();
    o[3] = MFB(pa3, g0, o[3]); Y0[15] = EX2(Y0[15]);
    asm volatile("" : "+v"(Y0), "+v"(Y1));
    SBAR();
#undef VF
}
__device__ __forceinline__ void body(const signed char* __restrict__ Qb, const signed char* __restrict__ Kh, const bf16_t* __restrict__ Vh, bf16_t* __restrict__ Ob, int seq, LAS unsigned char* L) {
    char* lds = (char*)L;
    int tid_ = threadIdx.x; asm volatile("" : "+v"(tid_));
    const int tid = tid_, wid = tid >> 6, lane = tid & 63, r32 = lane & 31, hi = lane >> 5;
    const int wu = __builtin_amdgcn_readfirstlane(wid);
    float* ws = (float*)(lds + WS_OFF) + wid * 64; float* li_l = ws; float* al_l = ws + 32;
    float m_reg = -1e30f, l_reg = 0; f32x16 o[4] = {}; i32x4 qr[6];
    const signed char* Qw = Qb + (long)(wid * QBLK + r32) * DQ + hi * 16;
#pragma unroll
    for (int ks = 0; ks < 6; ++ks) qr[ks] = *reinterpret_cast<const i32x4*>(Qw + ks * 32);
    i32x16 mg;
#pragma unroll
    for (int r = 0; r < 16; ++r) mg[r] = 0x4B400000;
    asm volatile("" : "+v"(mg));
    unsigned vsa, vsb, ksa, ksb;
    { const int d = (2 * wid) * 64 + lane, S = d >> 5, kk = (S >> 2) * 8 + ((d >> 2) & 7), c8 = (S & 3) * 4 + (d & 3), k = (kk & ~0xC) | ((kk & 4) << 1) | ((kk & 8) >> 1); vsa = (unsigned)(k * 256 + c8 * 16); }
    { const int d = (2 * wid + 1) * 64 + lane, S = d >> 5, kk = (S >> 2) * 8 + ((d >> 2) & 7), c8 = (S & 3) * 4 + (d & 3), k = (kk & ~0xC) | ((kk & 4) << 1) | ((kk & 8) >> 1); vsb = (unsigned)(k * 256 + c8 * 16); }
    { const int d = wid * 64 + lane, row = d / 13, pc = d - row * 13; ksa = (unsigned)(row * DQ + (pc < 12 ? pc : 11) * 16); }
    { const int d = (8 + (wid < 5 ? wid : 4)) * 64 + lane, row = d / 13, pc = d - row * 13; ksb = (unsigned)(row * DQ + (pc < 12 ? pc : 11) * 16); }
#define STAGE(k0, slot) do { const char* _vb = (const char*)Vh + (size_t)(k0) * DV * 2; const char* _kb = (const char*)Kh + (size_t)(k0) * DQ; \
    LAS unsigned char* _vd = L + (slot) * SHM_V + wu * 2048; LAS unsigned char* _kd = L + K_OFF + (slot) * SHM_K + wu * 1024; \
    __builtin_amdgcn_global_load_lds((const unsigned*)(_vb + vsa), (LAS unsigned*)_vd, 16, 0, 0); \
    __builtin_amdgcn_global_load_lds((const unsigned*)(_vb + vsb), (LAS unsigned*)(_vd + 1024), 16, 0, 0); \
    __builtin_amdgcn_global_load_lds((const unsigned*)(_kb + ksa), (LAS unsigned*)_kd, 16, 0, 0); \
    __builtin_amdgcn_global_load_lds((const unsigned*)(_kb + ksb), (LAS unsigned*)(L + K_OFF + (slot) * SHM_K + (8 + (wu < 5 ? wu : 4)) * 1024), 16, 0, 0); } while (0)
#define SWAIT() asm volatile("s_waitcnt vmcnt(0)" ::: "memory")
#define RESC(a) do { if (__any((a) < 1.f)) { if (hi == 0) al_l[r32] = (a); asm volatile("s_waitcnt lgkmcnt(0)" ::: "memory"); \
    _Pragma("unroll") for (int d = 0; d < 4; ++d) _Pragma("unroll") for (int r = 0; r < 16; ++r) o[d][r] *= al_l[crow(r, hi)]; } } while (0)
#define ROT() do { const int _t = b0; b0 = b1; b1 = b2; b2 = _t; } while (0)
    const int kl = K_OFF + r32 * KROW + hi * 16;
    const LAS unsigned char* vl = L + v_rd_base(lane);
#define HALF(X0, X1, alX, Y0, Y1, alY) do { \
    region1(Y0, Y1, X0, X1, alX, l_reg, pa0, pa1, pa2, pa3, lds + kl + b1 * SHM_K, qr, mg); \
    region2(o, Y0, Y1, m_reg, alY, pa0, pa1, pa2, pa3, vl + b0 * SHM_V); \
    RESC(alY); } while (0)
    f32x16 pA0, pA1, pB0, pB1; float alA, alB; bf16x8 pa0, pa1, pa2, pa3; const int NT_ = seq / KVBLK;
    int b0 = 0, b1 = 1, b2 = 2;
    STAGE(0, 0); STAGE(KVBLK, 1); SWAIT(); __syncthreads();
    {
        const char* kb = lds + kl; i32x16 a0, a1;
#pragma unroll
        for (int ks = 0; ks < 6; ++ks) { const i32x4 f0 = *reinterpret_cast<const i32x4*>(kb + ks * 32), f1 = *reinterpret_cast<const i32x4*>(kb + 32 * KROW + ks * 32);
            if (ks == 0) { a0 = MF8(f0, qr[0], mg); a1 = MF8(f1, qr[0], mg); } else { a0 = MF8(f0, qr[ks], a0); a1 = MF8(f1, qr[ks], a1); } }
        pA0 = __builtin_bit_cast(f32x16, a0); pA1 = __builtin_bit_cast(f32x16, a1);
        float pm = pA0[0], pn = pA0[1], mc;
        MAX8(pA0, 0); MAX8(pA0, 8); MAX8(pA1, 0); MAX8(pA1, 8);
        pm = fmaxf(pm, pn); { auto rr = __builtin_amdgcn_permlane32_swap(__float_as_uint(pm), __float_as_uint(pm), false, false); pm = fmaxf(__uint_as_float(rr[0]), __uint_as_float(rr[1])); }
        pm = (pm - MAGIC) * SC; m_reg = pm; alA = 0.f; mc = -(pm + MAGIC * SC);
        FMA8(pA0, 0); FMA8(pA0, 8); FMA8(pA1, 0); FMA8(pA1, 8); EXP4(pA0, 0); EXP4(pA0, 4); EXP4(pA0, 8); EXP4(pA0, 12);
    }
#pragma clang loop unroll(disable)
    for (int j = 1; j + 1 < NT_; j += 2) {
        STAGE((j + 1) * KVBLK, b2);
        HALF(pA0, pA1, alA, pB0, pB1, alB);
        SWAIT(); __syncthreads(); ROT();
        STAGE((j + 2) * KVBLK, b2);
        HALF(pB0, pB1, alB, pA0, pA1, alA);
        SWAIT(); __syncthreads(); ROT();
    }
    HALF(pA0, pA1, alA, pB0, pB1, alB);
    {
        float ps = 0.f, pt = 0.f;
        EXP4(pB1, 0); EXP4(pB1, 4); EXP4(pB1, 8); EXP4(pB1, 12); ADD8(pB0, 0); ADD8(pB0, 8); ADD8(pB1, 0); ADD8(pB1, 8);
        ps += pt; { auto rr = __builtin_amdgcn_permlane32_swap(__float_as_uint(ps), __float_as_uint(ps), false, false); ps = __uint_as_float(rr[0]) + __uint_as_float(rr[1]); } l_reg = l_reg * alB + ps;
        PK4(pB0, 0, pa0); PK4(pB0, 8, pa1); PK4(pB1, 0, pa2); PK4(pB1, 8, pa3);
        const LAS unsigned char* vp = vl + b1 * SHM_V;
#pragma unroll
        for (int d0 = 0; d0 < 4; ++d0) { o[d0] = MFB(pa0, vfrag(vp, v_rd_off(d0, 0, 0)), o[d0]); o[d0] = MFB(pa1, vfrag(vp, v_rd_off(d0, 1, 0)), o[d0]);
            o[d0] = MFB(pa2, vfrag(vp, v_rd_off(d0, 2, 0)), o[d0]); o[d0] = MFB(pa3, vfrag(vp, v_rd_off(d0, 3, 0)), o[d0]); }
    }
    if (hi == 0) li_l[r32] = l_reg; asm volatile("s_waitcnt lgkmcnt(0)" ::: "memory");
    __syncthreads();
    {
        char* ot = lds + wid * 8704;
#pragma unroll
        for (int r = 0; r < 16; ++r) { const int orow = crow(r, hi); const float rl = __builtin_amdgcn_rcpf(li_l[orow]);
#pragma unroll
            for (int d0 = 0; d0 < 4; ++d0) *(bf16_t*)(ot + orow * 272 + (d0 * 32 + r32) * 2) = (bf16_t)(cvt_pk_bf16(o[d0][r] * rl, 0.f) & 0xffffu); }
        asm volatile("s_waitcnt lgkmcnt(0)" ::: "memory");
        bf16_t* Ow = Ob + (long)(wid * QBLK) * 1024;
#pragma unroll
        for (int k = 0; k < 8; ++k) { const int row = 4 * k + (lane >> 4), ch = lane & 15;
            const u32x4 v = *(const u32x4*)(ot + row * 272 + ch * 16);
            *(u32x4*)(Ow + (long)row * 1024 + ch * 8) = v; }
    }
    __syncthreads();
#undef HALF
#undef ROT
#undef STAGE
#undef SWAIT
#undef RESC
}
#undef PK4
#undef FMA8
#undef MAX8
#undef ADD8
#undef EXP3
#undef EXP4
}

typedef short v4i16_t __attribute__((ext_vector_type(4)));
__device__ __forceinline__ s16x4 tr_rd(const LAS unsigned char* p) { return __builtin_bit_cast(s16x4, __builtin_amdgcn_ds_read_tr16_b64_v4i16((LAS v4i16_t*)p)); }
__device__ __forceinline__ int swz16(int r) { return ((r & 3) << 1) | (((r >> 3) & 1) << 3) | ((r >> 2) & 1); }
__device__ __forceinline__ int swzV(int k) { return (k & 3) | (((k >> 3) & 1) << 2); }
#define MFMA16(a, b, c) __builtin_amdgcn_mfma_f32_16x16x32_bf16((a), (b), (c), 0, 0, 0)
__device__ __forceinline__ bf16x8 mk8(u32x2 lo, u32x2 hi) { u32x4 w = {lo.x, lo.y, hi.x, hi.y}; return __builtin_bit_cast(bf16x8, w); }
__device__ __forceinline__ bf16x8 mk8s(s16x4 lo, s16x4 hi) { return (bf16x8){lo[0], lo[1], lo[2], lo[3], hi[0], hi[1], hi[2], hi[3]}; }

__device__ __forceinline__ void ret_scan_unit(Frame& F, int unit, const bf16_t* __restrict__ QK, const bf16_t* __restrict__ V, bf16_t* __restrict__ YF, bf16_t* __restrict__ YB, const float* __restrict__ decay_f, const float* __restrict__ decay_b) {
    constexpr int QS = 528, KS = 544, VS = 288, PS = 144;
    const int vs = unit & 3, dir = (unit >> 2) & 1, h = (unit >> 3) & 3, b = unit >> 5;
    float lg = -expf((dir ? decay_b : decay_f)[h]) * 1.4426950408889634f;
    const int lane = F.lane, w = F.wave, l15 = lane & 15, q4 = lane >> 4, tid = F.tid;
    LAS unsigned char* Qs = F.lds; LAS unsigned char* Ks = F.lds + 64 * QS; LAS unsigned char* Vs = Ks + 2 * 64 * KS; LAS unsigned char* Ps = Vs + 64 * VS;
    const float g64 = exp2f(lg * 64.f);
    f32x4 S[16];
#pragma unroll
    for (int i = 0; i < 16; ++i) S[i] = (f32x4){0.f, 0.f, 0.f, 0.f};
    bf16_t* Y = dir ? YB : YF;
    const int ti1 = w >> 1, tj0 = 2 * (w & 1);
    const LAS unsigned char* q128 = Qs + (16 * ti1 + l15) * QS + q4 * 16;
    const LAS unsigned char* k128 = Ks + (16 * tj0 + l15) * KS + q4 * 16;
    const LAS unsigned char* q64 = Qs + l15 * QS + q4 * 8;
    const LAS unsigned char* ktr = Ks + (4 * q4 + (l15 >> 2)) * KS + (l15 & 3) * 16;
    const LAS unsigned char* vtr = Vs + (4 * q4 + (l15 >> 2)) * VS + w * 32 + (l15 & 3) * 8;
    const LAS unsigned char* pA = Ps + l15 * PS + q4 * 8;
    LAS unsigned char* pW = Ps + (16 * ti1 + l15) * PS + (16 * tj0 + 4 * q4) * 2;
#define RS_ROW0(step) ({ const int _cc = (step) < 4 ? (dir ? 3 - (step) : (step)) : (dir ? 67 - (step) : (step) - 4); (step) < 4 ? NLAT + b * 256 + 64 * _cc : b * 4096 + 64 * _cc; })
    const int wu = __builtin_amdgcn_readfirstlane(w);
    unsigned qo[5], ko[5], vo[3];
#pragma unroll
    for (int i = 0; i < 5; ++i) { int ins = i * 8 + w; ins = ins > 32 ? 32 : ins; const int d = ins * 64 + lane, row = d / 33, pc = d - 33 * row; qo[i] = (unsigned)(row * 4096 + (pc < 32 ? pc : 31) * 16); }
#pragma unroll
    for (int i = 0; i < 5; ++i) { int ins = i * 8 + w; ins = ins > 33 ? 33 : ins; const int d = ins * 64 + lane, row = d / 34, pc = d - 34 * row; ko[i] = (unsigned)(row * 4096 + (pc < 32 ? pc : 31) * 16); }
#pragma unroll
    for (int i = 0; i < 3; ++i) { int ins = i * 8 + w; ins = ins > 17 ? 17 : ins; const int d = ins * 64 + lane, row = d / 18, pc = d - 18 * row; vo[i] = (unsigned)(row * 4096 + (pc < 16 ? pc : 15) * 16); }
    const char* Qg = (const char*)(QK + 256 * h); const char* Kg = (const char*)(QK + 1024 + 256 * h); const char* Vg = (const char*)(V + 512 * h + 128 * vs);
#define RS_DMA_Q(R0) do { _Pragma("unroll") for (int _i = 0; _i < 5; ++_i) { const int _s = _i * 8 + wu; \
        __builtin_amdgcn_global_load_lds((const unsigned*)(Qg + (size_t)(R0) * 4096 + qo[_i]), (LAS unsigned*)(Qs + (_s > 32 ? 32 : _s) * 1024), 16, 0, 0); } } while (0)
#define RS_DMA_K(R0, kb) do { _Pragma("unroll") for (int _i = 0; _i < 5; ++_i) { const int _s = _i * 8 + wu; \
        __builtin_amdgcn_global_load_lds((const unsigned*)(Kg + (size_t)(R0) * 4096 + ko[_i]), (LAS unsigned*)(Ks + (kb) + (_s > 33 ? 33 : _s) * 1024), 16, 0, 0); } } while (0)
#define RS_DMA_V(R0) do { _Pragma("unroll") for (int _i = 0; _i < 3; ++_i) { const int _s = _i * 8 + wu; \
        __builtin_amdgcn_global_load_lds((const unsigned*)(Vg + (size_t)(R0) * 4096 + vo[_i]), (LAS unsigned*)(Vs + (_s > 17 ? 17 : _s) * 1024), 16, 0, 0); } } while (0)
    { const int R0 = RS_ROW0(0); RS_DMA_Q(R0); RS_DMA_K(R0, 0); RS_DMA_V(R0); }
    asm volatile("s_waitcnt vmcnt(0)" ::: "memory");
    __syncthreads();
    for (int step = 0; step < 68; ++step) {
        const int R0 = RS_ROW0(step), R1 = RS_ROW0(step + 1 < 68 ? step + 1 : step), kbo = (step & 1) * (64 * KS);
        const bool more = step + 1 < 68;
        if (more) { RS_DMA_K(R1, (64 * KS) - kbo); }
#define SB0() __builtin_amdgcn_sched_barrier(0)
        f32x4 p0 = (f32x4){0.f, 0.f, 0.f, 0.f}, p1 = p0;
        {
            const LAS unsigned char* k128b = k128 + kbo;
            bf16x8 qa[8], kb0[8], kb1[8];
#define A1RD(s_) do { qa[s_] = *(const LAS bf16x8*)(q128 + (s_) * 64); kb0[s_] = *(const LAS bf16x8*)(k128b + (s_) * 64); kb1[s_] = *(const LAS bf16x8*)(k128b + 16 * KS + (s_) * 64); } while (0)
            A1RD(0); A1RD(1); A1RD(2);
#pragma unroll
            for (int ks = 0; ks < 8; ++ks) {
                if (ks + 3 < 8) A1RD(ks + 3);
                SB0();
                p0 = MFMA16(kb0[ks], qa[ks], p0); p1 = MFMA16(kb1[ks], qa[ks], p1);
                SB0();
            }
#undef A1RD
        }
        {
            const int dbase = dir ? (16 * tj0 + 4 * q4) - (16 * ti1 + l15) : (16 * ti1 + l15) - (16 * tj0 + 4 * q4);
#pragma unroll
            for (int t = 0; t < 2; ++t) {
                const f32x4 pv = t ? p1 : p0; float val[4];
#pragma unroll
                for (int rg = 0; rg < 4; ++rg) { const int d = dir ? dbase + 16 * t + rg : dbase - 16 * t - rg;
                    val[rg] = d >= 0 ? pv[rg] * __builtin_amdgcn_exp2f(lg * (float)d) : 0.f; }
                u32x2 pw; pw.x = cvt_pk_bf16(val[0], val[1]); pw.y = cvt_pk_bf16(val[2], val[3]);
                *(LAS u32x2*)(pW + t * 32) = pw;
            }
        }
        f32x4 y[4];
#pragma unroll
        for (int ti = 0; ti < 4; ++ti) y[ti] = (f32x4){0.f, 0.f, 0.f, 0.f};
        {
            const LAS unsigned char* qrow = Qs + l15 * QS + q4 * 16;
            bf16x8 qf[8][4];
#define A2RD(s_) do { _Pragma("unroll") for (int ti = 0; ti < 4; ++ti) qf[s_][ti] = *(const LAS bf16x8*)(qrow + ti * 16 * QS + (s_) * 64); } while (0)
            A2RD(0);
#pragma unroll
            for (int ks = 0; ks < 8; ++ks) {
                if (ks < 7) A2RD(ks + 1);
                u32x4 bw; bw.x = cvt_pk_bf16(S[2 * ks][0], S[2 * ks][1]); bw.y = cvt_pk_bf16(S[2 * ks][2], S[2 * ks][3]); bw.z = cvt_pk_bf16(S[2 * ks + 1][0], S[2 * ks + 1][1]); bw.w = cvt_pk_bf16(S[2 * ks + 1][2], S[2 * ks + 1][3]);
                const bf16x8 bfr = __builtin_bit_cast(bf16x8, bw);
                SB0();
#pragma unroll
                for (int ti = 0; ti < 4; ++ti) y[ti] = MFMA16(bfr, qf[ks][ti], y[ti]);
                SB0();
            }
#undef A2RD
        }
#pragma unroll
        for (int ti = 0; ti < 4; ++ti) { const int qi = 16 * ti + l15; y[ti] = y[ti] * __builtin_amdgcn_exp2f(lg * (float)(dir ? 64 - qi : qi + 1)); }
        if (more) asm volatile("s_waitcnt vmcnt(5) lgkmcnt(0)" ::: "memory"); else asm volatile("s_waitcnt vmcnt(0) lgkmcnt(0)" ::: "memory");
        __builtin_amdgcn_s_barrier(); asm volatile("" ::: "memory");
        if (more) { RS_DMA_Q(R1); }
        bf16x8 vf[2];
#pragma unroll
        for (int ks2 = 0; ks2 < 2; ++ks2) {
            const s16x4 lo = tr_rd(vtr + ks2 * 32 * VS);
            const s16x4 hi = tr_rd(vtr + ks2 * 32 * VS + 16 * VS);
            vf[ks2] = mk8s(lo, hi);
        }
#pragma unroll
        for (int ks2 = 0; ks2 < 2; ++ks2)
#pragma unroll
            for (int ti = 0; ti < 4; ++ti) {
                const u32x2 lo = *(const LAS u32x2*)(pA + ti * 16 * PS + ks2 * 64);
                const u32x2 hi = *(const LAS u32x2*)(pA + ti * 16 * PS + ks2 * 64 + 32);
                y[ti] = MFMA16(vf[ks2], mk8(lo, hi), y[ti]);
            }
        const LAS unsigned char* ktrb = ktr + kbo;
        SB0(); asm volatile("s_nop 15\n\ts_nop 7" ::: "memory"); SB0();
        {
            bf16_t* yp = Y + (size_t)(R0 + l15) * 2048 + 512 * h + 128 * vs + 16 * w + 4 * q4;
#pragma unroll
            for (int ti = 0; ti < 4; ++ti) { u32x2 yw; yw.x = cvt_pk_bf16(y[ti][0], y[ti][1]); yw.y = cvt_pk_bf16(y[ti][2], y[ti][3]); *(u32x2*)(yp + (size_t)(16 * ti) * 2048) = yw; }
        }
        bf16x8 vp[2];
        {
            const float dk0 = __builtin_amdgcn_exp2f(lg * (float)(dir ? 4 * q4 : 63 - 4 * q4));
            float dkj[8];
#pragma unroll
            for (int j = 0; j < 8; ++j) { const int dkk = (j & 3) + 16 * (j >> 2); dkj[j] = __builtin_amdgcn_exp2f(lg * (float)(dir ? dkk : -dkk)); }
            const float dk32 = __builtin_amdgcn_exp2f(lg * (float)(dir ? 32 : -32));
#pragma unroll
            for (int ks2 = 0; ks2 < 2; ++ks2) {
                const float bs = ks2 ? dk0 * dk32 : dk0;
                const u32x4 vw = __builtin_bit_cast(u32x4, vf[ks2]); u32x4 o;
                o.x = cvt_pk_bf16(bflo(vw.x) * (bs * dkj[0]), bfhi(vw.x) * (bs * dkj[1])); o.y = cvt_pk_bf16(bflo(vw.y) * (bs * dkj[2]), bfhi(vw.y) * (bs * dkj[3]));
                o.z = cvt_pk_bf16(bflo(vw.z) * (bs * dkj[4]), bfhi(vw.z) * (bs * dkj[5])); o.w = cvt_pk_bf16(bflo(vw.w) * (bs * dkj[6]), bfhi(vw.w) * (bs * dkj[7]));
                vp[ks2] = __builtin_bit_cast(bf16x8, o);
            }
        }
        {
            s16x4 kl[16][2], kh[16][2];
#define B2RD(d_) do { _Pragma("unroll") for (int ks2 = 0; ks2 < 2; ++ks2) { kl[d_][ks2] = tr_rd(ktrb + ks2 * 32 * KS + ((d_) >> 1) * 64 + ((d_) & 1) * 8); kh[d_][ks2] = tr_rd(ktrb + ks2 * 32 * KS + 16 * KS + ((d_) >> 1) * 64 + ((d_) & 1) * 8); } } while (0)
            B2RD(0); B2RD(1);
#pragma unroll
            for (int dt = 0; dt < 16; ++dt) {
                if (dt + 2 < 16) B2RD(dt + 2);
                S[dt] = S[dt] * g64;
                SB0();
#pragma unroll
                for (int ks2 = 0; ks2 < 2; ++ks2) S[dt] = MFMA16(mk8s(kl[dt][ks2], kh[dt][ks2]), vp[ks2], S[dt]);
                SB0();
            }
#undef B2RD
        }
#undef SB0
        asm volatile("s_waitcnt vmcnt(0) lgkmcnt(0)" ::: "memory");
        __builtin_amdgcn_s_barrier(); asm volatile("" ::: "memory");
        if (more) { RS_DMA_V(R1); }
    }
#undef RS_ROW0
#undef RS_DMA_Q
#undef RS_DMA_K
#undef RS_DMA_V
}

__device__ __forceinline__ void readout_row(const bf16_t* yf, const bf16_t* yb, const unsigned char* g, signed char* o8, float* osp, int lane) {
    u32x4 a[4], bq[4]; u32x2 gf[4], gb[4];
#pragma unroll
    for (int hh = 0; hh < 4; ++hh) { a[hh] = *(const u32x4*)(yf + 512 * hh + 8 * lane); bq[hh] = *(const u32x4*)(yb + 512 * hh + 8 * lane);
        gf[hh] = *(const u32x2*)(g + 512 * hh + 8 * lane); gb[hh] = *(const u32x2*)(g + 2048 + 512 * hh + 8 * lane); }
    float sa[4], sb[4];
#pragma unroll
    for (int hh = 0; hh < 4; ++hh) { float x = 0.f, y = 0.f;
#pragma unroll
        for (int i = 0; i < 4; ++i) { const float a0 = bflo(a[hh][i]), a1 = bfhi(a[hh][i]), b0 = bflo(bq[hh][i]), b1 = bfhi(bq[hh][i]); x += a0 * a0 + a1 * a1; y += b0 * b0 + b1 * b1; }
        sa[hh] = x; sb[hh] = y; }
#pragma unroll
    for (int of = 1; of < 64; of <<= 1) {
#pragma unroll
        for (int hh = 0; hh < 4; ++hh) { sa[hh] += __shfl_xor(sa[hh], of); sb[hh] += __shfl_xor(sb[hh], of); }
    }
    float ov[4][8]; float m = 0.f;
#pragma unroll
    for (int hh = 0; hh < 4; ++hh) {
        const float ra = rsqrtf(sa[hh] * (1.f / 512.f) + EPS), rb = rsqrtf(sb[hh] * (1.f / 512.f) + EPS);
#pragma unroll
        for (int i = 0; i < 4; ++i) {
            const f32x2 gfv = (i & 1) ? __builtin_amdgcn_cvt_pk_f32_fp8((int)gf[hh][i >> 1], true) : __builtin_amdgcn_cvt_pk_f32_fp8((int)gf[hh][i >> 1], false);
            const f32x2 gbv = (i & 1) ? __builtin_amdgcn_cvt_pk_f32_fp8((int)gb[hh][i >> 1], true) : __builtin_amdgcn_cvt_pk_f32_fp8((int)gb[hh][i >> 1], false);
            ov[hh][2 * i] = siluf(gfv.x) * bflo(a[hh][i]) * ra + siluf(gbv.x) * bflo(bq[hh][i]) * rb;
            ov[hh][2 * i + 1] = siluf(gfv.y) * bfhi(a[hh][i]) * ra + siluf(gbv.y) * bfhi(bq[hh][i]) * rb;
            m = fmaxf(m, fmaxf(fabsf(ov[hh][2 * i]), fabsf(ov[hh][2 * i + 1])));
        }
    }
    m = wave_max(m);
    const float sc = m > 0.f ? m * (1.f / 127.f) : 1.f, inv = 1.f / sc;
#pragma unroll
    for (int hh = 0; hh < 4; ++hh) { u32x2 w; w.x = pack_i8x4(ov[hh][0] * inv, ov[hh][1] * inv, ov[hh][2] * inv, ov[hh][3] * inv); w.y = pack_i8x4(ov[hh][4] * inv, ov[hh][5] * inv, ov[hh][6] * inv, ov[hh][7] * inv);
        *(u32x2*)(o8 + 512 * hh + 8 * lane) = w; }
    if (lane == 0) *osp = sc;
}

__global__ void __launch_bounds__(NTHR, 2) fwd_kernel(Args args) {
    extern __shared__ __attribute__((aligned(16))) unsigned char lds_raw[];
    Frame F;
    F.lds = (LAS unsigned char*)lds_raw;
    F.tid = threadIdx.x; F.lane = F.tid & 63; F.wave = __builtin_amdgcn_readfirstlane(F.tid >> 6);
    F.G = gridDim.x; { const int bx = blockIdx.x; F.vcu = (F.G % 8 == 0) ? (bx % 8) * (F.G / 8) + bx / 8 : bx; }
    F.ws = args.ws; F.ctl = (unsigned*)(args.ws + WS_CTL);
    volatile LAS unsigned* MISC = (volatile LAS unsigned*)(F.lds + LDSCTL_OFF);
    for (int u = F.tid; u < (LDS_BYTES - LDSCTL_OFF) / 4; u += NTHR) ((LAS unsigned*)(F.lds + LDSCTL_OFF))[u] = 0u;
    __syncthreads();
    XcdBarrier bar; bar.bar = F.ctl + CW_BAR; bar.x = 0; bar.st = nullptr;
    if (MK_ONE_LAUNCH) bar = xcd_barrier_post(F.ctl + CW_BAR, MISC + 8);
    const int lo = args.ph_lo, hi = args.ph_hi;
#ifndef PHMASK
#define PHMASK 0xffffffffu
#endif
#define IN(k) (((PHMASK >> (k)) & 1u) && lo <= (k) && (k) < hi)
#define SEAM(k) do { if (MK_ONE_LAUNCH && IN((k) + 1)) xcd_barrier(bar); } while (0)

    const float* x = (const float*)args.in[0]; const float* c = (const float*)args.in[1]; const float* ctx = (const float*)args.in[2]; const float* c_ctx = (const float*)args.in[3];
    const float* ada_w = (const float*)args.in[4]; const float* ada_b = (const float*)args.in[5]; const float* norm_mix = (const float*)args.in[6]; const float* norm_ffn = (const float*)args.in[7];
    float* MOD = (float*)(F.ws + WS_MOD);
    bf16_t* H = (bf16_t*)(F.ws + WS_H);
    signed char* H8 = (signed char*)(F.ws + WS_H8); float* HS = (float*)(F.ws + WS_HS); signed char* O8 = (signed char*)(F.ws + WS_O); float* OS = (float*)(F.ws + WS_OS);
    bf16_t* XB = (bf16_t*)(F.ws + WS_XB);
    float* out = args.out;
    const int gw = F.vcu * NWAVES + F.wave, NGW = F.G * NWAVES;

    if (IN(0)) {
        mod_vectors(F, c, c_ctx, ada_w, ada_b, MOD);
        __syncthreads();
        rope_tables(F, (f32x2*)(F.ws + WS_TABR), (f32x2*)(F.ws + WS_TABM));
        {
        int cb = 0;
        conv_job(F, cb, (const float*)args.in[14], (bf16_t*)(F.ws + WS_W_QB), 384, 1536, 1536, 0, 1, 0, 0, (const float*)args.in[13]);
        conv_job(F, cb, (const float*)args.in[16], (bf16_t*)(F.ws + WS_W_KVB), 256, 2048, 2048, 0, 1, 0, 0, (const float*)args.in[15]);
        conv_job(F, cb, (const float*)args.in[19], (bf16_t*)(F.ws + WS_W_MO), 1024, 1024, 1024, 0, 1, 0, 0);
        conv_job(F, cb, (const float*)args.in[20], (bf16_t*)(F.ws + WS_W_RT), 1024, 64, 256, 3, 2, (size_t)1024 * 64, (size_t)256 * 1024);
        conv_job(F, cb, (const float*)args.in[25], (bf16_t*)(F.ws + WS_W_SD), 256, 1024, 1024, 0, 2, (size_t)256 * 1024, (size_t)1024 * 256);
        conv_job(F, cb, (const float*)args.in[23], (bf16_t*)(F.ws + WS_W_ED), 256, 1024, 1024, 0, 64, (size_t)256 * 1024, (size_t)1024 * 256);
        __syncthreads();
        int c8 = 0;
        conv8_job<2, true>(F, c8, (const float*)args.in[8], (signed char*)(F.ws + WS_W_RI8), (float*)(F.ws + WS_CS_RI), 1024, 8192, 8192, 1, 1, 0);
        conv8_job<4, false>(F, c8, (const float*)args.in[11], (signed char*)(F.ws + WS_W_RO8), (float*)(F.ws + WS_CS_RO), 2048, 1024, 1024, 0, 1, 0);
        conv8_job<2, true>(F, c8, (const float*)args.in[12], (signed char*)(F.ws + WS_W_MI8), (float*)(F.ws + WS_CS_MI), 1024, 704, 768, 3, 1, 0);
        conv8_job<2, true>(F, c8, (const float*)args.in[24], (signed char*)(F.ws + WS_W_SGU8), (float*)(F.ws + WS_CS_SGU), 1024, 512, 512, 2, 2, (size_t)1024 * 512);
        conv8_job<2, true>(F, c8, (const float*)args.in[22], (signed char*)(F.ws + WS_W_EGU8), (float*)(F.ws + WS_CS_EGU), 1024, 512, 512, 2, 64, (size_t)1024 * 512);
        }
        SEAM(0);
    }
    if (IN(1)) {
        for (int rep = 0; rep < PROBE_REPS(1); ++rep)
        for (int r = gw; r < NT; r += NGW) {
            const float* xr = r < NLAT ? x + (size_t)r * DM : ctx + (size_t)(r - NLAT) * DM;
            const float* md = MOD + (size_t)(0 * 9 + mod_row_of(r)) * 6144;
            norm_mod_row(xr, norm_mix, md, md + 1024, nullptr, H8 + (size_t)r * DM, HS + r, F.lane);
        }
        SEAM(1);
    }
    bf16_t* QKb = (bf16_t*)(F.ws + WS_QK); bf16_t* Vb = (bf16_t*)(F.ws + WS_V); bf16_t* Gb = (bf16_t*)(F.ws + WS_G);
    bf16_t* YFb = (bf16_t*)(F.ws + WS_YF); bf16_t* YBb = (bf16_t*)(F.ws + WS_YB); bf16_t* Ob = (bf16_t*)(F.ws + WS_O);
    if (IN(2)) {
        g8::DenseSched S; S.init(H8, 512, F.ws + WS_W_RI8, 512, NT, RET_IN, F.G, (int)blockIdx.x, HS, (const float*)(F.ws + WS_CS_RI));
        EpiRetProj E{QKb, Vb, Gb, (const f32x4*)(F.ws + WS_TABR)};
        g8::gemm_phase<true>(F.lds, 512, 512, 512, S, E);
        SEAM(2);
    }
    if (IN(3)) {
        for (int rep = 0; rep < PROBE_REPS(3); ++rep)
        for (int u = F.vcu; u < 256; u += F.G) ret_scan_unit(F, u, QKb, Vb, YFb, YBb, (const float*)args.in[9], (const float*)args.in[10]);
        SEAM(3);
    }
    if (IN(4)) {
        for (int rep = 0; rep < PROBE_REPS(4); ++rep)
        for (int r = gw; r < NT; r += NGW) readout_row(YFb + (size_t)r * 2048, YBb + (size_t)r * 2048, (const unsigned char*)Gb + (size_t)r * 4096, O8 + (size_t)r * 2048, OS + r, F.lane);
        SEAM(4);
    }
    if (IN(5)) {
        g8::DenseSched S; S.init(O8, 1024, F.ws + WS_W_RO8, 1024, NT, DM, F.G, (int)blockIdx.x, OS, (const float*)(F.ws + WS_CS_RO));
        EpiResid<false> E{x, ctx, XB, MOD + 2 * 1024};
        g8::gemm_phase<true>(F.lds, 1024, 1024, 1024, S, E);
        SEAM(5);
    }
    float* LOGIT = (float*)(F.ws + WS_LOGIT); int* RTP = (int*)(F.ws + WS_RT_P); int* LIST = (int*)(F.ws + WS_LIST); float* RTW = (float*)(F.ws + WS_LISTW); float* LISTS = (float*)(F.ws + WS_LISTS); int* DEST = (int*)(F.ws + WS_DEST);
    bf16_t* ACT = (bf16_t*)(F.ws + WS_ACT); unsigned char* YS = (unsigned char*)(F.ws + WS_YS);
    const float* router_bias = (const float*)args.in[21];
    if (IN(6)) {
        for (int c0 = F.vcu; c0 < NT / 136; c0 += F.G) { norm_router_block(F, 0, c0 * 136, 136, XB, norm_ffn, MOD, (const bf16_t*)(F.ws + WS_W_RT), H8, HS, LOGIT);
            route_block(F, 0, c0 * 136, 136, LOGIT, router_bias, LIST, RTW, DEST, HS, LISTS); }
        SEAM(8);
    }
    if (IN(9)) {
        build_tpre(F, 0, NT);
        g8::GroupSched<true> S; S.tpre = (const LAS int*)(F.lds + LDS_TPRE); S.cnts = (const LAS int*)(F.lds + LDS_CNTS);
        S.A = (const char*)H8; S.B = (const char*)(F.ws + WS_W_EGU8); S.Bsh = (const char*)(F.ws + WS_W_SGU8); S.list = LIST; S.lda = 512; S.ldb = 512; S.ncu = 2; S.bexp = (size_t)512 * 1024; S.G = F.G; S.c = F.vcu; S.total = S.tpre[65] * 2;
        S.rs = HS; S.rsls = LISTS; S.cs = (const float*)(F.ws + WS_CS_EGU); S.cssh = (const float*)(F.ws + WS_CS_SGU); S.ncols = 512;
        EpiAct E{ACT};
        g8::gemm_phase<true>(F.lds, 512, 512, 512, S, E);
        SEAM(9);
    }
    if (IN(10)) {
        build_tpre(F, 0, NT);
        g8::GroupSched<false> S; S.tpre = (const LAS int*)(F.lds + LDS_TPRE); S.cnts = (const LAS int*)(F.lds + LDS_CNTS);
        S.A = (const char*)ACT; S.B = (const char*)(F.ws + WS_W_ED); S.Bsh = (const char*)(F.ws + WS_W_SD); S.list = nullptr; S.lda = 256; S.ldb = 256; S.ncu = 4; S.bexp = (size_t)1024 * 256 * 2; S.G = F.G; S.c = F.vcu; S.total = S.tpre[65] * 4; S.rs = nullptr; S.rsls = nullptr; S.cs = nullptr; S.cssh = nullptr; S.ncols = 0;
        EpiDown E{YS, DEST}; g8::gemm_phase<false>(F.lds, 256, 256, 256, S, E);
        SEAM(10);
    }
    if (IN(11)) {
        build_tpre(F, 0, NT);
        for (int r = gw; r < NT; r += NGW) {
            bf16_t* xr = XB + (size_t)r * DM;
            const float* md0 = MOD + (size_t)(0 * 9 + mod_row_of(r)) * 6144; const float* md1 = MOD + (size_t)(1 * 9 + mod_row_of(r)) * 6144;
            combine_row<false>(F, RTW, r, YS, xr, nullptr, xr, md0 + 5 * 1024, true, norm_mix + DM, md1, md1 + 1024, H8 + (size_t)r * DM, HS + r);
        }
        __syncthreads();
        int cb = 0;
        conv_job(F, cb, (const float*)args.in[23] + (size_t)64 * 256 * 1024, (bf16_t*)(F.ws + WS_W_ED), 256, 1024, 1024, 0, 64, (size_t)256 * 1024, (size_t)1024 * 256);
        __syncthreads();
        int c8 = 0;
        conv8_job<2, true>(F, c8, (const float*)args.in[22] + (size_t)64 * 1024 * 512, (signed char*)(F.ws + WS_W_EGU8), (float*)(F.ws + WS_CS_EGU), 1024, 512, 512, 2, 64, (size_t)1024 * 512);
        SEAM(11);
    }
    bf16_t* Abuf = (bf16_t*)(F.ws + WS_A); bf16_t* AQN = (bf16_t*)(F.ws + WS_AQN); bf16_t* AKVN = (bf16_t*)(F.ws + WS_AKVN); bf16_t* KROPE = (bf16_t*)(F.ws + WS_KROPE);
    bf16_t* QRAW = (bf16_t*)(F.ws + WS_QRAW); bf16_t* KVRAW = (bf16_t*)(F.ws + WS_KVRAW); signed char* QF = (signed char*)(F.ws + WS_QF); signed char* KF = (signed char*)(F.ws + WS_KF); bf16_t* VF = (bf16_t*)(F.ws + WS_VF);
    bf16_t* OATT = (bf16_t*)(F.ws + WS_OATT);
    const f32x2* TABM = (const f32x2*)(F.ws + WS_TABM);
    if (IN(12)) {
        g8::DenseSched S; S.init(H8, 512, F.ws + WS_W_MI8, 512, NT, MLA_INP, F.G, (int)blockIdx.x, HS, (const float*)(F.ws + WS_CS_MI)); EpiStore E{Abuf, MLA_INP}; g8::gemm_phase<true>(F.lds, 512, 512, 512, S, E);
        SEAM(12);
    }
    if (IN(14)) {
        for (int rep = 0; rep < 1; ++rep) {
        { g8::DenseSched S; S.init(Abuf, MLA_INP, F.ws + WS_W_QB, MLA_QR, NLAT, 1536, F.G, (int)blockIdx.x); EpiStore E{QRAW, 1536}; g8::gemm_phase<false>(F.lds, MLA_QR, MLA_INP, MLA_QR, S, E); if ((PROBE_MASK >> 14) & 1u) g8::gemm_phase<false>(F.lds, MLA_QR, MLA_QR, MLA_QR, S, E); }
        { g8::DenseSched S; S.init(Abuf + MLA_QR, MLA_INP, F.ws + WS_W_KVB, MLA_KVR, NT, 2048, F.G, (int)blockIdx.x); EpiStore E{KVRAW, 2048}; g8::gemm_phase<false>(F.lds, MLA_KVR, MLA_INP, MLA_KVR, S, E); if ((PROBE_MASK >> 14) & 1u) g8::gemm_phase<false>(F.lds, MLA_KVR, MLA_KVR, MLA_KVR, S, E); }
        }
        SEAM(14);
    }
    if (IN(15)) {
        for (int rep = 0; rep < PROBE_REPS(15); ++rep)
        for (int r = gw; r < NT; r += 2 * NGW) {
            mla_final_row(r, Abuf, QRAW, KVRAW, (const float*)args.in[17], (const float*)args.in[18], TABM, QF, KF, VF, F.lane);
            if (r + NGW < NT) mla_final_row(r + NGW, Abuf, QRAW, KVRAW, (const float*)args.in[17], (const float*)args.in[18], TABM, QF, KF, VF, F.lane); }
        SEAM(15);
    }
    if (IN(16)) {
        for (int rep = 0; rep < PROBE_REPS(16); ++rep)
        for (int u = F.vcu; u < 1024; u += F.G) { const int bh = u >> 4, qb = u & 15, b = bh >> 3, h = bh & 7;
            att::body(QF + ((size_t)bh * 4096 + qb * 256) * 192, KF + (size_t)bh * SKV * 192, VF + (size_t)bh * SKV * 128, OATT + ((size_t)b * 4096 + qb * 256) * 1024 + h * 128, SKV, F.lds); }
        SEAM(16);
    }
    if (IN(17)) {
        g8::DenseSched S; S.init(OATT, DM, F.ws + WS_W_MO, DM, NLAT, DM, F.G, (int)blockIdx.x); EpiResid<true> E{nullptr, nullptr, XB, MOD + 9 * 6144 + 2 * 1024}; g8::gemm_phase<false>(F.lds, DM, DM, DM, S, E);
        SEAM(17);
    }
    if (IN(18)) {
        for (int c0 = F.vcu; c0 < NLAT / 128; c0 += F.G) { norm_router_block(F, 1, c0 * 128, 128, XB, norm_ffn + DM, MOD + (size_t)9 * 6144, (const bf16_t*)(F.ws + WS_W_RT) + (size_t)256 * 1024, H8, HS, LOGIT);
            route_block(F, 1, c0 * 128, 128, LOGIT, router_bias + 64, LIST, RTW, DEST, HS, LISTS); }
        SEAM(20);
    }
    if (IN(21)) {
        build_tpre(F, 1, NLAT);
        g8::GroupSched<true> S; S.tpre = (const LAS int*)(F.lds + LDS_TPRE); S.cnts = (const LAS int*)(F.lds + LDS_CNTS);
        S.A = (const char*)H8; S.B = (const char*)(F.ws + WS_W_EGU8); S.Bsh = (const char*)(F.ws + WS_W_SGU8 + (size_t)512 * 1024); S.list = LIST; S.lda = 512; S.ldb = 512; S.ncu = 2; S.bexp = (size_t)512 * 1024; S.G = F.G; S.c = F.vcu; S.total = S.tpre[65] * 2;
        S.rs = HS; S.rsls = LISTS; S.cs = (const float*)(F.ws + WS_CS_EGU); S.cssh = (const float*)(F.ws + WS_CS_SGU) + 512; S.ncols = 512;
        EpiAct E{ACT};
        g8::gemm_phase<true>(F.lds, 512, 512, 512, S, E);
        SEAM(21);
    }
    if (IN(22)) {
        build_tpre(F, 1, NLAT);
        g8::GroupSched<false> S; S.tpre = (const LAS int*)(F.lds + LDS_TPRE); S.cnts = (const LAS int*)(F.lds + LDS_CNTS);
        S.A = (const char*)ACT; S.B = (const char*)(F.ws + WS_W_ED); S.Bsh = (const char*)(F.ws + WS_W_SD + (size_t)1024 * 256 * 2); S.list = nullptr; S.lda = 256; S.ldb = 256; S.ncu = 4; S.bexp = (size_t)1024 * 256 * 2; S.G = F.G; S.c = F.vcu; S.total = S.tpre[65] * 4; S.rs = nullptr; S.rsls = nullptr; S.cs = nullptr; S.cssh = nullptr; S.ncols = 0;
        EpiDown E{YS, DEST}; g8::gemm_phase<false>(F.lds, 256, 256, 256, S, E);
        SEAM(22);
    }
    if (IN(23)) {
        build_tpre(F, 1, NLAT);
        for (int r = gw; r < NLAT; r += NGW) { const float* md1 = MOD + (size_t)(1 * 9 + (r >> 12)) * 6144;
            combine_row<true>(F, RTW, r, YS, XB + (size_t)r * DM, out + (size_t)r * DM, nullptr, md1 + 5 * 1024, false, norm_mix, md1, md1, H8, HS); }
    }
#undef IN
#undef SEAM
}

constexpr int N_PHASES = 24;
extern "C" void kernel_launch(void* const* d_in, const int* in_sizes, int n_in, void* d_out, int out_size, void* d_ws, size_t ws_size, hipStream_t stream) {
    static int grid = 0;
    if (grid == 0) {
        if (n_in != 26 || out_size != NLAT * DM || ws_size < WS_END) { fprintf(stderr, "kernel_launch: unexpected shapes: n_in %d out %d ws %zu (need %zu)\n", n_in, out_size, ws_size, (size_t)WS_END); grid = -1; return; }
        int dev = 0, cus = 0, per_cu = 0;
        if (hipGetDevice(&dev) != hipSuccess || hipDeviceGetAttribute(&cus, hipDeviceAttributeMultiprocessorCount, dev) != hipSuccess) { grid = -1; return; }
        if (hipFuncSetAttribute((const void*)fwd_kernel, hipFuncAttributeMaxDynamicSharedMemorySize, LDS_BYTES) != hipSuccess) { fprintf(stderr, "kernel_launch: hipFuncSetAttribute failed\n"); grid = -1; return; }
        if (hipOccupancyMaxActiveBlocksPerMultiprocessor(&per_cu, (const void*)fwd_kernel, NTHR, LDS_BYTES) != hipSuccess || per_cu < 1) fprintf(stderr, "kernel_launch: occupancy query says %d\n", per_cu);
        (void)hipGetLastError();
        grid = cus;
    }
    if (grid < 0) return;
    (void)hipMemsetAsync((char*)d_ws + WS_CTL, 0, CTL_ZERO_BYTES, stream);
    Args a{};
    for (int i = 0; i < 26; ++i) a.in[i] = d_in[i];
    a.out = (float*)d_out; a.ws = (unsigned char*)d_ws;
    const int last = N_PHASES < MK_LAST_PHASE ? N_PHASES : MK_LAST_PHASE;
    if (MK_ONE_LAUNCH) {
        a.ph_lo = 0; a.ph_hi = last;
        hipLaunchKernelGGL(fwd_kernel, dim3(grid), dim3(NTHR), LDS_BYTES, stream, a);
    } else {
        for (int p = 0; p < last; ++p) { a.ph_lo = p; a.ph_hi = p + 1; hipLaunchKernelGGL(fwd_kernel, dim3(grid), dim3(NTHR), LDS_BYTES, stream, a); }
    }
    const hipError_t le = hipPeekAtLastError();
    if (le != hipSuccess) fprintf(stderr, "kernel_launch: launch failed: %s\n", hipGetErrorName(le));
}
```

```cpp
#include <hip/hip_runtime.h>
#include <cstdio>
#include <cstdint>

#ifndef MK_ONE_LAUNCH
#define MK_ONE_LAUNCH 1
#endif
#ifndef PROBE_MASK
#define PROBE_MASK 0u
#endif
#define PROBE_REPS(k) (((PROBE_MASK >> (k)) & 1u) ? 2 : 1)
#ifndef MK_LAST_PHASE
#define MK_LAST_PHASE 99
#endif

#define LAS __attribute__((address_space(3)))
#define GAS __attribute__((address_space(1)))
typedef unsigned short bf16_t;
typedef short bf16x8 __attribute__((ext_vector_type(8)));
typedef short s16x4 __attribute__((ext_vector_type(4)));
typedef float f32x4 __attribute__((ext_vector_type(4)));
typedef float f32x2 __attribute__((ext_vector_type(2)));
typedef float f32x16 __attribute__((ext_vector_type(16)));
typedef unsigned u32x4 __attribute__((ext_vector_type(4)));
typedef unsigned u32x2 __attribute__((ext_vector_type(2)));
typedef int i32x4 __attribute__((ext_vector_type(4)));

constexpr int DM = 1024, NB = 8, SEQ = 4096, CTXL = 256;
constexpr int NLAT = NB * SEQ;
constexpr int NCTX = NB * CTXL;
constexpr int NT = NLAT + NCTX;
constexpr int RET_H = 4, RET_DK = 256, RET_DV = 512, RET_VW = 2048, RET_IN = 8192;
constexpr int MLA_H = 8, MLA_NOPE = 128, MLA_ROPE = 64, MLA_QK = 192, MLA_V = 128, MLA_QR = 384, MLA_KVR = 256, MLA_IN = 704, MLA_INP = 768;
constexpr int SKV = SEQ + CTXL;
constexpr int NE = 64, TOPK = 8, EFF = 256;
constexpr float EPS = 1e-6f;
constexpr int NWAVES = 8, NTHR = 512;

constexpr size_t MiB = 1u << 20;
constexpr size_t WS_CTL = 0, CTL_ZERO_BYTES = 1 * MiB;
constexpr size_t WS_MOD = 1 * MiB;
constexpr size_t WS_TABR = 1 * MiB + 512 * 1024;
constexpr size_t WS_TABM = WS_TABR + 64 * 64 * 8;
constexpr size_t WS_W_RI8 = 2 * MiB, WS_CS_RI = 10 * MiB;
constexpr size_t WS_W_RO8 = 11 * MiB, WS_CS_RO = 13 * MiB;
constexpr size_t WS_W_MI8 = 14 * MiB, WS_CS_MI = 15 * MiB;
constexpr size_t WS_W_QB = 16 * MiB;
constexpr size_t WS_W_KVB = 18 * MiB;
constexpr size_t WS_W_MO = 19 * MiB;
constexpr size_t WS_W_RT = 21 * MiB;
constexpr size_t WS_W_SGU8 = 22 * MiB, WS_CS_SGU = 23 * MiB;
constexpr size_t WS_W_SD = 24 * MiB;
constexpr size_t WS_W_EGU8 = 26 * MiB, WS_CS_EGU = 58 * MiB;
constexpr size_t WS_W_ED = 59 * MiB;
constexpr size_t WS_H8 = 92 * MiB, WS_HS = 126 * MiB;
constexpr size_t WS_OS = 127 * MiB;
constexpr size_t WS_H = 130 * MiB;
constexpr size_t WS_R = 198 * MiB;
constexpr size_t WS_XC = 1014 * MiB;
constexpr size_t WS_END = 1022 * MiB;
constexpr size_t WS_QK = WS_R, WS_V = WS_R + 136 * MiB, WS_G = WS_R + 272 * MiB, WS_YF = WS_R + 544 * MiB, WS_YB = WS_R + 680 * MiB;
constexpr size_t WS_O = WS_QK;
constexpr int MOE_ROWS = 294912 + NT;
constexpr size_t WS_RT_P = WS_R;
constexpr size_t WS_LISTW = WS_R + 2 * MiB;
constexpr size_t WS_ACT = WS_R + 11 * MiB;
constexpr size_t WS_YS = WS_R + 172 * MiB;
constexpr size_t WS_LOGIT = WS_YS;
constexpr size_t WS_LIST = WS_YS + 16 * MiB;
constexpr size_t WS_LISTS = WS_YS + 330 * MiB;
static_assert((size_t)MOE_ROWS * 1024 <= 330 * MiB && WS_LISTS + (size_t)64 * NT * 4 <= WS_XC, "ws map");
static_assert(WS_ACT + (size_t)MOE_ROWS * 512 <= WS_YS && WS_YS + (size_t)MOE_ROWS * 2048 <= WS_XC, "ws map");
constexpr size_t WS_A = WS_R;
constexpr size_t WS_AQN = WS_R + 52 * MiB;
constexpr size_t WS_AKVN = WS_R + 76 * MiB;
constexpr size_t WS_KROPE = WS_R + 93 * MiB;
constexpr size_t WS_QRAW = WS_R + 98 * MiB;
constexpr size_t WS_KVRAW = WS_R + 194 * MiB;
constexpr size_t WS_QF = WS_R + 330 * MiB;
constexpr size_t WS_KF = WS_R + 426 * MiB;
constexpr size_t WS_VF = WS_R + 528 * MiB;
constexpr size_t WS_OATT = WS_R + 596 * MiB;
constexpr size_t WS_XB = WS_R + 700 * MiB;
static_assert(WS_OATT + (size_t)NLAT * 1024 * 2 <= WS_XB && WS_LISTS + (size_t)64 * NT * 4 <= WS_XB && WS_XB + (size_t)NT * 1024 * 2 <= WS_XC, "ws map");
constexpr int CW_BAR = 4096;
constexpr int CW_CNT = 8192;
constexpr int RING_BYTES = 131072, LDSCTL_OFF = RING_BYTES, LDS_BYTES = 147456;

__device__ __forceinline__ unsigned cvt_pk_bf16(float lo, float hi) { unsigned r; asm volatile("v_cvt_pk_bf16_f32 %0, %1, %2" : "=v"(r) : "v"(lo), "v"(hi)); return r; }
__device__ __forceinline__ float bf2f(bf16_t b) { return __uint_as_float(((unsigned)b) << 16); }
__device__ __forceinline__ float bflo(unsigned w) { return __uint_as_float(w << 16); }
__device__ __forceinline__ float bfhi(unsigned w) { return __uint_as_float(w & 0xffff0000u); }
__device__ __forceinline__ float wave_sum(float v) {
#pragma unroll
    for (int o = 1; o < 64; o <<= 1) v += __shfl_xor(v, o);
    return v;
}
__device__ __forceinline__ float siluf(float x) { return x * __builtin_amdgcn_rcpf(1.f + __builtin_amdgcn_exp2f(-1.4426950408889634f * x)); }
#define LDS_WAIT() asm volatile("s_waitcnt lgkmcnt(0)" ::: "memory")
#define VM_WAIT() asm volatile("s_waitcnt vmcnt(0)" ::: "memory")

#define XB_TMO      128
#define XB_XCNT(j)  (256  + 64 * (j))
#define XB_XSUB(j)  (1280 + 64 * (j))
#define XB_XGEN(j)  (2304 + 64 * (j))
#define XB_TOP      3328
#define XB_TOPGEN   3392
#define XCD_BAR_WORDS 3456
#define XB_SPIN_CAP (1u << 22)
__device__ __forceinline__ unsigned xb_ld(unsigned* p)              { return __hip_atomic_load(p, __ATOMIC_RELAXED, __HIP_MEMORY_SCOPE_AGENT); }
__device__ __forceinline__ unsigned xb_add(unsigned* p, unsigned v) { return __hip_atomic_fetch_add(p, v, __ATOMIC_RELAXED, __HIP_MEMORY_SCOPE_AGENT); }
__device__ __forceinline__ unsigned xb_xcc_id() { return (unsigned)__builtin_amdgcn_s_getreg((3 << 11) | 20) & 0xFu; }
#define XB_SPIN(cond, bar) do { unsigned _sp = 0; while (cond) { __builtin_amdgcn_s_sleep(1); \
    if ((++_sp & 255u) == 0u) { if (xb_ld(&(bar)[XB_TMO])) break; if (_sp > XB_SPIN_CAP) { atomicAdd(&(bar)[XB_TMO], 1u); break; } } } } while (0)
struct XcdBarrier { unsigned* bar; unsigned x; volatile LAS unsigned* st; };
__device__ __forceinline__ XcdBarrier xcd_barrier_post(unsigned* bar, volatile LAS unsigned* st) {
    XcdBarrier b; b.bar = bar; b.x = xb_xcc_id(); b.st = st;
    if (threadIdx.x == 0) (void)xb_add(&bar[XB_XCNT(b.x)], 1u);
    return b;
}
__device__ __forceinline__ void xcd_barrier_complete(unsigned* bar, unsigned x, unsigned& nloc, unsigned& nx) {
    const unsigned G = gridDim.x * gridDim.y * gridDim.z;
    unsigned sum, cnt, mine, sp = 0u;
    for (;;) {
        sum = 0u; cnt = 0u; mine = 0u;
#pragma unroll
        for (unsigned j = 0; j < 16; ++j) { const unsigned c = xb_ld(&bar[XB_XCNT(j)]); sum += c; cnt += (c > 0u) ? 1u : 0u; mine = (j == x) ? c : mine; }
        if (sum == G) break;
        __builtin_amdgcn_s_sleep(1);
        if ((++sp & 255u) == 0u) { if (xb_ld(&bar[XB_TMO])) break; if (sp > XB_SPIN_CAP) { atomicAdd(&bar[XB_TMO], 1u); break; } }
    }
    nloc = mine > 0u ? mine : 1u; nx = cnt > 0u ? cnt : 1u;
}
__device__ __forceinline__ void xcd_barrier(const XcdBarrier& b) {
    asm volatile("s_waitcnt vmcnt(0)" ::: "memory");
    __syncthreads();
    if (threadIdx.x == 0) {
        unsigned* bar = b.bar;
        __builtin_amdgcn_s_waitcnt(0);
        unsigned nloc = b.st[0], nx = b.st[1];
        if (nloc == 0u) { xcd_barrier_complete(bar, b.x, nloc, nx); b.st[0] = nloc; b.st[1] = nx; }
        const unsigned old = xb_add(&bar[XB_XSUB(b.x)], 1u);
        const unsigned gen = old / nloc;
        if (old + 1u == (gen + 1u) * nloc) {
            __builtin_amdgcn_fence(__ATOMIC_RELEASE, "agent");
            asm volatile("s_waitcnt vmcnt(0)" ::: "memory");
            const unsigned og = xb_add(&bar[XB_TOP], 1u);
            const unsigned tg = og / nx;
            if (og + 1u == (tg + 1u) * nx) xb_add(&bar[XB_TOPGEN], 1u);
            else XB_SPIN(xb_ld(&bar[XB_TOPGEN]) == tg, bar);
            __builtin_amdgcn_fence(__ATOMIC_ACQUIRE, "agent");
            xb_add(&bar[XB_XGEN(b.x)], 1u);
            asm volatile("s_waitcnt vmcnt(0)" ::: "memory");
        } else {
            XB_SPIN(xb_ld(&bar[XB_XGEN(b.x)]) == gen, bar);
            __builtin_amdgcn_fence(__ATOMIC_ACQUIRE, "agent");
            asm volatile("s_waitcnt vmcnt(0)" ::: "memory");
        }
    }
    __syncthreads();
}

namespace g8 {
constexpr int BM = 256, BK = 64, HALF = 128, HTB = HALF * BK * 2, STAGE_BYTES = 8 * HTB;
__host__ __device__ __forceinline__ int lds_byte(int r, int c) { const int st = (r >> 4) * 2 + (c >> 5), rr = r & 15, cc = c & 31, ob = rr * 64 + cc * 2; return st * 1024 + (ob ^ (((ob >> 9) & 1) << 5)); }
__host__ __device__ __forceinline__ void stage_rc(int b, int& R, int& C) { const int st = b / 1024, sb = b % 1024, swz = sb ^ (((sb >> 9) & 1) << 5); R = (st >> 1) * 16 + swz / 64; C = (st & 1) * 32 + (swz % 64) / 2; }
__host__ __device__ __forceinline__ int perm32(int rho) { const int n = rho >> 4, i = rho & 15; return 8 * (i >> 2) + 4 * n + (i & 3); }

struct Unit {
    const char* A;
    const char* B;
    const int* list;
    int row0, col0;
    int nvalid;
    int rbase;
    int aux;
    const float* rsl;
    const float* cs;
};

template <class E> struct epi_nst { static constexpr int value = 0; };
template <int N> __device__ __forceinline__ void g8_wait_v() { asm volatile("s_waitcnt vmcnt(%0)" :: "n"(N) : "memory"); }
template <bool I8, class Epi, class Sched>
__device__ __forceinline__ void gemm_phase(LAS unsigned char* lds, const int K_in, const int lda, const int ldb, const Sched& S, const Epi& E) {
    int K = K_in; asm volatile("" : "+s"(K));
    const int tid = threadIdx.x, wid = __builtin_amdgcn_readfirstlane(tid >> 6), lane = tid & 63, wr = wid >> 2, wc = wid & 3, fr = lane & 15, fq = lane >> 4;
    const int nt = K / BK;
    int Rst[2], Cst[2]; unsigned voffB[2];
#pragma unroll
    for (int i = 0; i < 2; ++i) { int R, C; stage_rc(tid * 16 + i * 8192, R, C); Rst[i] = R; Cst[i] = C; const int Rb = Epi::PERM == 2 ? (64 * (R >> 5) + 16 * ((R >> 2) & 3) + 4 * ((R >> 4) & 1) + (R & 3)) : Epi::PERM == 1 ? ((R & ~31) + perm32(R & 31)) : R; voffB[i] = (unsigned)(Rb * ldb + C) * 2u; }
    const size_t kstep = (size_t)(BK * 2);
    const size_t hstepB = (size_t)(Epi::PERM == 2 ? 8 : HALF) * ldb * 2;
    const unsigned ldsw = (unsigned)wid * 1024u;
    const int aoff = lds_byte(wr * 64 + fr, fq * 8), boff = lds_byte(wc * 32 + fr, fq * 8);
#define G8_SA(b, h) (((b) * 2 + (h)) * HTB)
#define G8_SB(b, h) ((4 + (b) * 2 + (h)) * HTB)
#define G8_STAGE(bufoff, gbase, voff) do { _Pragma("unroll") for (int _i = 0; _i < 2; ++_i) { unsigned _o = (voff)[_i]; asm volatile("" : "+v"(_o));     \
        __builtin_amdgcn_global_load_lds((const unsigned*)((const char*)(gbase) + _o), (LAS unsigned*)(lds + (bufoff) + ldsw + _i * 8192), 16, 0, 0); } } while (0)
#define G8_LDA(dst, b, h) do { _Pragma("unroll") for (int m = 0; m < 4; ++m) _Pragma("unroll") for (int k = 0; k < 2; ++k) dst[m][k] = *(const LAS bf16x8*)(lds + G8_SA(b, h) + aoff + m * 2048 + k * 1024); } while (0)
#define G8_LDB(dst, b, h) do { _Pragma("unroll") for (int n = 0; n < 2; ++n) _Pragma("unroll") for (int k = 0; k < 2; ++k) dst[n][k] = *(const LAS bf16x8*)(lds + G8_SB(b, h) + boff + n * 2048 + k * 1024); } while (0)
#define G8_MMA(ai, bj, At, Bt) do { __builtin_amdgcn_s_setprio(1); _Pragma("unroll") for (int m = 0; m < 4; ++m) _Pragma("unroll") for (int n = 0; n < 2; ++n) _Pragma("unroll") for (int k = 0; k < 2; ++k) { \
        if constexpr (I8) acc[ai][bj][m][n] = __builtin_bit_cast(f32x4, __builtin_amdgcn_mfma_i32_16x16x64_i8(__builtin_bit_cast(i32x4, Bt[n][k]), __builtin_bit_cast(i32x4, At[m][k]), __builtin_bit_cast(i32x4, acc[ai][bj][m][n]), 0, 0, 0)); \
        else acc[ai][bj][m][n] = __builtin_amdgcn_mfma_f32_16x16x32_bf16(Bt[n][k], At[m][k], acc[ai][bj][m][n], 0, 0, 0); } __builtin_amdgcn_s_setprio(0); } while (0)
#define G8_MMAZ(ai, bj, At, Bt) do { __builtin_amdgcn_s_setprio(1); _Pragma("unroll") for (int m = 0; m < 4; ++m) _Pragma("unroll") for (int n = 0; n < 2; ++n) { \
        if constexpr (I8) { acc[ai][bj][m][n] = __builtin_bit_cast(f32x4, __builtin_amdgcn_mfma_i32_16x16x64_i8(__builtin_bit_cast(i32x4, Bt[n][0]), __builtin_bit_cast(i32x4, At[m][0]), (i32x4){0, 0, 0, 0}, 0, 0, 0)); \
            acc[ai][bj][m][n] = __builtin_bit_cast(f32x4, __builtin_amdgcn_mfma_i32_16x16x64_i8(__builtin_bit_cast(i32x4, Bt[n][1]), __builtin_bit_cast(i32x4, At[m][1]), __builtin_bit_cast(i32x4, acc[ai][bj][m][n]), 0, 0, 0)); } \
        else { acc[ai][bj][m][n] = __builtin_amdgcn_mfma_f32_16x16x32_bf16(Bt[n][0], At[m][0], (f32x4){0.f, 0.f, 0.f, 0.f}, 0, 0, 0); \
            acc[ai][bj][m][n] = __builtin_amdgcn_mfma_f32_16x16x32_bf16(Bt[n][1], At[m][1], acc[ai][bj][m][n], 0, 0, 0); } } __builtin_amdgcn_s_setprio(0); } while (0)
#define G8_WAIT_V(n) asm volatile("s_waitcnt vmcnt(" #n ")" ::: "memory")
#define G8_WAIT_L(n) asm volatile("s_waitcnt lgkmcnt(" #n ")" ::: "memory")
#define G8_BAR __builtin_amdgcn_s_barrier()
#define G8_SCHED __builtin_amdgcn_sched_barrier(0)
#define G8_AOFF(u, dst) do { _Pragma("unroll") for (int _h = 0; _h < 2; ++_h) _Pragma("unroll") for (int _i = 0; _i < 2; ++_i) { \
        int _r = Rst[_i] + HALF * _h; if (Sched::GATHER) { _r = (u).list ? ((_r < (u).nvalid) ? (u).list[_r] : 0) : (u).rbase + _r; } \
        dst[_h][_i] = (unsigned)(_r * lda + Cst[_i]) * 2u; } } while (0)
    constexpr bool AUX = I8;
    LAS unsigned char* const side = lds + (LDSCTL_OFF + 4096);
#define G8_AUX(u, par) do { LAS unsigned char* _sb = side + (par) * 3072; \
        if (wid < 4) { if (Sched::GATHER && (u).list) __builtin_amdgcn_global_load_lds((const unsigned*)((u).list + 64 * wid + lane), (LAS unsigned*)(_sb + wid * 256), 4, 0, 0); \
            __builtin_amdgcn_global_load_lds((const unsigned*)((u).cs + 64 * wid + lane), (LAS unsigned*)(_sb + 2048 + wid * 256), 4, 0, 0); } \
        else __builtin_amdgcn_global_load_lds((const unsigned*)((u).rsl + 64 * (wid - 4) + lane), (LAS unsigned*)(_sb + 1024 + (wid - 4) * 256), 4, 0, 0); } while (0)
#define G8_AOFF_L(u, par, dst) do { const LAS int* _sl = (const LAS int*)(side + (par) * 3072); _Pragma("unroll") for (int _h = 0; _h < 2; ++_h) _Pragma("unroll") for (int _i = 0; _i < 2; ++_i) { \
        int _r = Rst[_i] + HALF * _h; if (Sched::GATHER) { _r = (u).list ? ((_r < (u).nvalid) ? _sl[_r] : 0) : (u).rbase + _r; } \
        dst[_h][_i] = (unsigned)(_r * lda + Cst[_i]) * 2u; } } while (0)
    Unit cur, nxt; int ui = 0;
    if (!S.next(0, cur)) return;
    constexpr bool ZC = !(I8 && Sched::GATHER);
    f32x4 acc[2][2][4][2];
#pragma unroll
    for (int a = 0; a < 2; ++a)
#pragma unroll
        for (int b = 0; b < 2; ++b)
#pragma unroll
            for (int m = 0; m < 4; ++m)
#pragma unroll
                for (int n = 0; n < 2; ++n) acc[a][b][m][n] = (f32x4){0.f, 0.f, 0.f, 0.f};
    bf16x8 At[4][2], B0[2][2], B1[2][2];
    unsigned ao[2][2], an[2][2];
    if constexpr (AUX) { G8_AUX(cur, 0); G8_WAIT_V(0); G8_BAR; G8_AOFF_L(cur, 0, ao); } else { G8_AOFF(cur, ao); }
    const char* cA = cur.A; const char* cB = cur.B;
    G8_STAGE(G8_SB(0, 0), cB, voffB); G8_STAGE(G8_SB(0, 1), cB + hstepB, voffB); G8_STAGE(G8_SA(0, 0), cA, ao[0]); G8_STAGE(G8_SA(0, 1), cA, ao[1]);
    if (wr == 1) G8_BAR;
    G8_WAIT_V(2); G8_BAR;
    G8_STAGE(G8_SB(1, 0), cB + kstep, voffB); G8_STAGE(G8_SA(1, 0), cA + kstep, ao[0]); G8_STAGE(G8_SB(1, 1), cB + hstepB + kstep, voffB);
    G8_WAIT_V(6); G8_BAR;
    for (;;) {
        const bool has_next = S.next(ui + 1, nxt);
        const char* nA = has_next ? nxt.A : cA; const char* nB = has_next ? nxt.B : cB;
        if constexpr (Sched::GATHER && !AUX) { if (has_next) { G8_AOFF(nxt, an); } }
        if (!Sched::GATHER || !has_next) {
#pragma unroll
            for (int h = 0; h < 2; ++h)
#pragma unroll
                for (int i = 0; i < 2; ++i) an[h][i] = ao[h][i]; }
        for (int t = 0; t < nt; t += 2) {
            const bool last = (t == nt - 2);
            if constexpr (AUX && Sched::GATHER) { if (last && has_next) { G8_AOFF_L(nxt, (ui + 1) & 1, an); } }
            const char* a1 = cA + (size_t)(t + 1) * kstep;
            const char* a2 = last ? nA : cA + (size_t)(t + 2) * kstep; const char* b2 = last ? nB : cB + (size_t)(t + 2) * kstep;
            const char* a3 = a2 + kstep; const char* b3 = b2 + kstep;
            unsigned a2o[2][2];
#pragma unroll
            for (int h = 0; h < 2; ++h)
#pragma unroll
                for (int i = 0; i < 2; ++i) a2o[h][i] = (Sched::GATHER && last) ? an[h][i] : ao[h][i];
            constexpr int NST = epi_nst<Epi>::value; const bool relax = NST > 0 && t == 0 && ui > 0;
            G8_LDB(B0, 0, 0); G8_LDB(B1, 0, 1); G8_SCHED; G8_LDA(At, 0, 0); G8_STAGE(G8_SA(1, 1), a1, ao[1]);
            if (relax) g8_wait_v<NST + 2>(); else G8_WAIT_V(8); G8_WAIT_L(0); G8_BAR; if (ZC && t == 0) { G8_MMAZ(0, 0, At, B0); G8_MMAZ(0, 1, At, B1); } else { G8_MMA(0, 0, At, B0); G8_MMA(0, 1, At, B1); } G8_BAR; G8_SCHED;
            if constexpr (AUX) { if (t == 0 && has_next) { G8_AUX(nxt, (ui + 1) & 1); } }
            G8_LDA(At, 0, 1); G8_STAGE(G8_SB(0, 0), b2, voffB); G8_STAGE(G8_SB(0, 1), b2 + hstepB, voffB); G8_STAGE(G8_SA(0, 0), a2, a2o[0]);
            if (relax) g8_wait_v<NST + 8>(); else G8_WAIT_V(8); G8_WAIT_L(0); G8_BAR; if (ZC && t == 0) { G8_MMAZ(1, 0, At, B0); G8_MMAZ(1, 1, At, B1); } else { G8_MMA(1, 0, At, B0); G8_MMA(1, 1, At, B1); } G8_BAR; G8_SCHED;
            G8_LDB(B0, 1, 0); G8_LDB(B1, 1, 1); G8_SCHED; G8_LDA(At, 1, 0); G8_STAGE(G8_SA(0, 1), a2, a2o[1]);
            if (relax) g8_wait_v<NST + 10>(); else G8_WAIT_V(8); G8_WAIT_L(0); G8_BAR; G8_MMA(0, 0, At, B0); G8_MMA(0, 1, At, B1); G8_BAR; G8_SCHED;
            G8_LDA(At, 1, 1); G8_STAGE(G8_SB(1, 0), b3, voffB); G8_STAGE(G8_SB(1, 1), b3 + hstepB, voffB); G8_STAGE(G8_SA(1, 0), a3, a2o[0]);
            G8_WAIT_V(8); G8_WAIT_L(0); G8_BAR; G8_MMA(1, 0, At, B0); G8_MMA(1, 1, At, B1); G8_BAR; G8_SCHED;
        }
        if (wr == 0) G8_BAR;
        if constexpr (I8) {
            const LAS unsigned char* sb = side + (ui & 1) * 3072;
            f32x4 csv[2][2];
#pragma unroll
            for (int bj = 0; bj < 2; ++bj)
#pragma unroll
                for (int n = 0; n < 2; ++n) { const int cidx = (Epi::PERM == 2 ? 64 * wc + 16 * fq + 8 * bj + 4 * n : bj * 128 + wc * 32 + (Epi::PERM == 1 ? 8 * fq + 4 * n : 16 * n + 4 * fq));
                    if constexpr (AUX) csv[bj][n] = *(const LAS f32x4*)(sb + 2048 + 4 * cidx); else csv[bj][n] = *(const f32x4*)(cur.cs + cidx); }
#pragma unroll
            for (int ai = 0; ai < 2; ++ai)
#pragma unroll
                for (int m = 0; m < 4; ++m) {
                    const int r = ai * 128 + wr * 64 + m * 16 + fr;
                    float rsv; if constexpr (AUX) rsv = *(const LAS float*)(sb + 1024 + 4 * r); else rsv = cur.rsl[r];
#pragma unroll
                    for (int bj = 0; bj < 2; ++bj)
#pragma unroll
                        for (int n = 0; n < 2; ++n) { const i32x4 iv = __builtin_bit_cast(i32x4, acc[ai][bj][m][n]);
                            acc[ai][bj][m][n] = (f32x4){(float)iv.x, (float)iv.y, (float)iv.z, (float)iv.w} * csv[bj][n] * rsv; }
                }
        }
        E(acc, cur, wr, wc, fr, fq);
        if (!has_next) break;
        if constexpr (!ZC) {
#pragma unroll
            for (int a = 0; a < 2; ++a)
#pragma unroll
                for (int b = 0; b < 2; ++b)
#pragma unroll
                    for (int m = 0; m < 4; ++m)
#pragma unroll
                        for (int n = 0; n < 2; ++n) acc[a][b][m][n] = (f32x4){0.f, 0.f, 0.f, 0.f};
        }
        cur = nxt; cA = nA; cB = nB; ++ui;
        if (wr == 1) G8_BAR;
#pragma unroll
        for (int h = 0; h < 2; ++h)
#pragma unroll
            for (int i = 0; i < 2; ++i) ao[h][i] = an[h][i];
    }
    G8_WAIT_V(0);
    G8_BAR;
#undef G8_SA
#undef G8_SB
#undef G8_STAGE
#undef G8_LDA
#undef G8_LDB
#undef G8_MMA
#undef G8_MMAZ
#undef G8_WAIT_V
#undef G8_WAIT_L
#undef G8_BAR
#undef G8_SCHED
#undef G8_AOFF
#undef G8_AOFF_L
#undef G8_AUX
}

struct DenseSched {
    static constexpr bool GATHER = false;
    const char* A; const char* B; int lda, ldb;
    const float* rs; const float* cs;
    int nM, nN, nwg, G, c;
    __device__ void init(const void* A_, int lda_, const void* B_, int ldb_, int M, int N, int G_, int c_, const float* rs_ = nullptr, const float* cs_ = nullptr) { A = (const char*)A_; B = (const char*)B_; lda = lda_; ldb = ldb_; nM = M / BM; nN = N / BM; nwg = nM * nN; G = G_; c = c_; rs = rs_; cs = cs_; }
    __device__ __forceinline__ bool next(int i, Unit& u) const {
        const int L = i * G + c; if (L >= nwg) return false;
        int wgid = L; { const int q = nwg / 8, r = nwg % 8, xcd = wgid % 8, off = wgid / 8; wgid = (xcd < r ? xcd * (q + 1) : r * (q + 1) + (xcd - r) * q) + off; }
        const int nig = 8 * nN, gid = wgid / nig, fm = gid * 8, gsz = (nM - fm) < 8 ? (nM - fm) : 8;
        const int pm = fm + ((wgid % nig) % gsz), pn = (wgid % nig) / gsz;
        u.A = A + (size_t)pm * BM * lda * 2; u.B = B + (size_t)pn * BM * ldb * 2; u.list = nullptr; u.row0 = pm * BM; u.col0 = pn * BM; u.nvalid = BM; u.rbase = pm * BM; u.aux = 0; u.rsl = rs + pm * BM; u.cs = cs + pn * BM; return true;
    }
};

template <bool GATH> struct GroupSched {
    static constexpr bool GATHER = GATH;
    const LAS int* tpre; const LAS int* cnts;
    const char* A; const char* B; const char* Bsh; const int* list; int lda, ldb, ncu; size_t bexp;
    const float* rs; const float* rsls; const float* cs; const float* cssh; int ncols;
    int G, c, total;
    __device__ __forceinline__ bool next(int i, Unit& u) const {
        const int L = i * G + c; if (L >= total) return false;
        const int tg = L / ncu, cu = L % ncu, lane = threadIdx.x & 63;
        const int t0 = tpre[lane], t1 = tpre[lane + 1];
        const unsigned long long m = __ballot(t0 <= tg && tg < t1);
        const int e = m ? __builtin_amdgcn_readfirstlane((int)__builtin_ctzll(m)) : 64;
        const int tile = tg - tpre[e], cn = cnts[e];
        u.nvalid = (cn - tile * 256) < 256 ? (cn - tile * 256) : 256;
        u.list = (e < 64 && list) ? list + (size_t)e * NT + tile * 256 : nullptr; u.rbase = tile * 256;
        u.A = GATH ? A : A + (size_t)tg * 256 * lda * 2;
        u.B = (e < 64 ? B + (size_t)e * bexp : Bsh) + (size_t)cu * 256 * ldb * 2;
        u.row0 = tg * 256; u.col0 = cu * 256; u.aux = e; u.rsl = e < 64 ? rsls + (size_t)e * NT + tile * 256 : rs + tile * 256; u.cs = (e < 64 ? cs + (size_t)e * ncols : cssh) + cu * 256; return true;
    }
};
}

struct Args { const void* in[26]; float* out; unsigned char* ws; int ph_lo, ph_hi; };
struct Frame {
    LAS unsigned char* lds;
    unsigned* ctl;
    unsigned char* ws;
    int tid, lane, wave, vcu, G;
};

__device__ __forceinline__ void conv_tile(const float* W, int K, int N, bf16_t* Bt, int n0, int k0, int kind, LAS unsigned char* T, int lane, const float* kscale) {
    const int g16 = lane & 15, kp = lane >> 4;
    int srcc, orow0, ostep = 1;
    if (kind == 1 && n0 < 2048) { const int hb = n0 & ~255, p0 = n0 & 255, a = p0 >> 7, i0 = (p0 & 127) >> 1, t = g16 >> 3; srcc = hb + 128 * a + 64 * t + i0 + (g16 & 7) * 4; orow0 = 8 * (g16 & 7) + t; ostep = 2; }
    else if (kind == 2) { const int u = n0 >> 8, cc = n0 & 255; srcc = (cc < 128 ? 128 * u + cc : 256 + 128 * u + (cc - 128)) + g16 * 4; orow0 = g16 * 4; }
    else { srcc = n0 + g16 * 4; orow0 = g16 * 4; }
    const bool valid = srcc < N;
    f32x4 v0[8], v1[8];
#pragma unroll
    for (int i = 0; i < 8; ++i) { const int k = k0 + 8 * i + 2 * kp;
        v0[i] = valid ? *(const f32x4*)(W + (size_t)k * N + srcc) : (f32x4){0.f, 0.f, 0.f, 0.f};
        v1[i] = valid ? *(const f32x4*)(W + (size_t)(k + 1) * N + srcc) : (f32x4){0.f, 0.f, 0.f, 0.f};
        if (kscale) { v0[i] = v0[i] * kscale[k]; v1[i] = v1[i] * kscale[k + 1]; } }
#pragma unroll
    for (int i = 0; i < 8; ++i) { const int kk = 8 * i + 2 * kp;
#pragma unroll
        for (int j = 0; j < 4; ++j) *(LAS unsigned*)(T + (orow0 + ostep * j) * 144 + kk * 2) = cvt_pk_bf16(v0[i][j], v1[i][j]); }
    LDS_WAIT(); asm volatile("" ::: "memory");
#pragma unroll
    for (int j = 0; j < 8; ++j) { const int n = 8 * j + (lane >> 3), c = lane & 7;
        const u32x4 o = *(const LAS u32x4*)(T + n * 144 + c * 16);
        *(u32x4*)(Bt + (size_t)(n0 + n) * K + k0 + 8 * c) = o; }
    LDS_WAIT(); asm volatile("" ::: "memory");
}
__device__ __forceinline__ void conv_job(Frame& F, int& base, const float* W, bf16_t* Bt, int K, int N, int nOut, int kind, int count, size_t wstride, size_t bstride, const float* kscale = nullptr) {
    LAS unsigned char* T = F.lds + F.wave * 16384;
    const int gw = F.vcu * NWAVES + F.wave, NGW = F.G * NWAVES;
    const int nnb = nOut / 64, per = nnb * (K / 64), tot = per * count;
    int it = gw - (base % NGW); if (it < 0) it += NGW;
    for (; it < tot; it += NGW) {
        const int mi = it / per, r = it % per, nb = r % nnb, kb = r / nnb;
        conv_tile(W + (size_t)mi * wstride, K, N, Bt + (size_t)mi * bstride, nb * 64, kb * 64, kind, T, F.lane, kscale);
    }
    base += tot;
}

template <int TPW, bool HOLD>
__device__ __forceinline__ void conv8_item(Frame& F, const float* W, int K, int N, signed char* B8, float* cs, int n0, int kind) {
    const int lane = F.lane, g16 = lane & 15, kp = lane >> 4;
    LAS float* cmax = (LAS float*)F.lds; LAS unsigned char* T = F.lds + 4096 + F.wave * 5120;
    int srcc, orow0, ostep = 1;
    if (kind == 1 && n0 < 2048) { const int hb = n0 & ~255, p0 = n0 & 255, a = p0 >> 7, i0 = (p0 & 127) >> 1, t = g16 >> 3; srcc = hb + 128 * a + 64 * t + i0 + (g16 & 7) * 4; orow0 = 8 * (g16 & 7) + t; ostep = 2; }
    else if (kind == 2) { const int u = n0 >> 8, cc = n0 & 255; srcc = (cc < 128 ? 128 * u + cc : 256 + 128 * u + (cc - 128)) + g16 * 4; orow0 = g16 * 4; }
    else { srcc = n0 + g16 * 4; orow0 = g16 * 4; }
    const bool valid = srcc < N;
    const float* wp = W + (size_t)(F.wave * TPW * 64 + 2 * kp) * N + (valid ? srcc : 0);
    f32x4 mx = (f32x4){0.f, 0.f, 0.f, 0.f};
#define C8_EMIT(x0, x1, tt) do { const int k0 = (F.wave * TPW + (tt)) * 64; \
        _Pragma("unroll") for (int i = 0; i < 8; ++i) { const int kk = 8 * i + 2 * kp; \
            _Pragma("unroll") for (int j = 0; j < 4; ++j) { const int q0 = (int)rintf(x0[i][j] * inv[j]), q1 = (int)rintf(x1[i][j] * inv[j]); \
                *(LAS unsigned short*)(T + (orow0 + ostep * j) * 80 + kk) = (unsigned short)((q0 & 255) | ((q1 & 255) << 8)); } } \
        LDS_WAIT(); asm volatile("" ::: "memory"); \
        _Pragma("unroll") for (int jj = 0; jj < 4; ++jj) { const int n = (lane >> 2) + 16 * jj, c = lane & 3; \
            *(u32x4*)(B8 + (size_t)(n0 + n) * K + k0 + 16 * c) = *(const LAS u32x4*)(T + n * 80 + c * 16); } \
        LDS_WAIT(); asm volatile("" ::: "memory"); } while (0)
#define C8_LOAD(x0, x1, tt) do { _Pragma("unroll") for (int i = 0; i < 8; ++i) { x0[i] = *(const f32x4*)(wp + (size_t)((tt) * 64 + 8 * i) * N); x1[i] = *(const f32x4*)(wp + (size_t)((tt) * 64 + 8 * i + 1) * N); } } while (0)
#define C8_MAX(x0, x1) do { _Pragma("unroll") for (int i = 0; i < 8; ++i) _Pragma("unroll") for (int j = 0; j < 4; ++j) mx[j] = fmaxf(mx[j], fmaxf(fabsf(x0[i][j]), fabsf(x1[i][j]))); } while (0)
#define C8_REDUCE() do { if (!valid) mx = (f32x4){0.f, 0.f, 0.f, 0.f}; \
        _Pragma("unroll") for (int j = 0; j < 4; ++j) { mx[j] = fmaxf(mx[j], __shfl_xor(mx[j], 16)); mx[j] = fmaxf(mx[j], __shfl_xor(mx[j], 32)); } \
        if (kp == 0) { _Pragma("unroll") for (int j = 0; j < 4; ++j) cmax[F.wave * 64 + orow0 + ostep * j] = mx[j]; } \
        __syncthreads(); \
        _Pragma("unroll") for (int j = 0; j < 4; ++j) { float m = 0.f; \
            _Pragma("unroll") for (int w = 0; w < 8; ++w) m = fmaxf(m, cmax[w * 64 + orow0 + ostep * j]); \
            const float sc = m > 0.f ? m * (1.f / 127.f) : 1.f; inv[j] = valid ? 1.f / sc : 0.f; \
            if (F.wave == 0 && kp == 0) cs[n0 + orow0 + ostep * j] = sc; } } while (0)
    f32x4 inv;
    if constexpr (HOLD && TPW == 2) {
        f32x4 xa0[8], xa1[8], xb0[8], xb1[8];
        C8_LOAD(xa0, xa1, 0); C8_LOAD(xb0, xb1, 1);
        C8_MAX(xa0, xa1); C8_MAX(xb0, xb1);
        C8_REDUCE();
        C8_EMIT(xa0, xa1, 0); C8_EMIT(xb0, xb1, 1);
    } else {
#pragma clang loop unroll(disable)
        for (int t = 0; t < TPW; ++t) { f32x4 x0[8], x1[8]; C8_LOAD(x0, x1, t); C8_MAX(x0, x1); }
        C8_REDUCE();
#pragma clang loop unroll(disable)
        for (int t = 0; t < TPW; ++t) { f32x4 x0[8], x1[8]; C8_LOAD(x0, x1, t); C8_EMIT(x0, x1, t); }
    }
    __syncthreads();
#undef C8_EMIT
#undef C8_LOAD
#undef C8_MAX
#undef C8_REDUCE
}
template <int TPW, bool HOLD>
__device__ __forceinline__ void conv8_job(Frame& F, int& base, const float* W, signed char* B8, float* cs, int K, int N, int nOut, int kind, int count, size_t wstride) {
    const int per = nOut / 64, tot = per * count;
    int it = F.vcu - (base % F.G); if (it < 0) it += F.G;
    for (; it < tot; it += F.G) { const int mi = it / per, nb = it % per;
        conv8_item<TPW, HOLD>(F, W + (size_t)mi * wstride, K, N, B8 + (size_t)mi * nOut * K, cs + (size_t)mi * nOut, nb * 64, kind); }
    base += tot;
}
__device__ __forceinline__ float wave_max(float v) {
#pragma unroll
    for (int o = 1; o < 64; o <<= 1) v = fmaxf(v, __shfl_xor(v, o));
    return v;
}
__device__ __forceinline__ unsigned pack_i8x4(float a, float b, float c, float d) { return ((unsigned)(int)rintf(a) & 255u) | (((unsigned)(int)rintf(b) & 255u) << 8) | (((unsigned)(int)rintf(c) & 255u) << 16) | ((unsigned)(int)rintf(d) << 24); }
__device__ __forceinline__ void quant_row_store(const f32x4 (&a)[4], signed char* h8row, float* hsp, int lane) {
    float m = 0.f;
#pragma unroll
    for (int j = 0; j < 4; ++j) m = fmaxf(m, fmaxf(fmaxf(fabsf(a[j].x), fabsf(a[j].y)), fmaxf(fabsf(a[j].z), fabsf(a[j].w))));
    m = wave_max(m);
    const float sc = m > 0.f ? m * (1.f / 127.f) : 1.f, inv = 1.f / sc;
#pragma unroll
    for (int j = 0; j < 4; ++j) *(unsigned*)(h8row + 4 * lane + 256 * j) = pack_i8x4(a[j].x * inv, a[j].y * inv, a[j].z * inv, a[j].w * inv);
    if (lane == 0) *hsp = sc;
}

__device__ __forceinline__ void mod_vectors(Frame& F, const float* c, const float* c_ctx, const float* ada_w, const float* ada_b, float* MOD) {
    LAS float* sc = (LAS float*)F.lds;
    LAS float* red = (LAS float*)(F.lds + 40960);
    bool loaded = false;
    for (int item = F.vcu; item < 96; item += F.G) {
        if (!loaded) { for (int i = F.tid; i < 9 * 1024; i += NTHR) { const float v = (i < 8192) ? c[i] : c_ctx[i - 8192]; sc[i] = siluf(v); } loaded = true; __syncthreads(); }
        const int layer = item / 48, cb = item % 48, col = cb * 128 + (F.tid & 127), kq = F.tid >> 7;
        const float* W = ada_w + (size_t)layer * 1024 * 6144 + col;
        float a[9];
#pragma unroll
        for (int r = 0; r < 9; ++r) a[r] = 0.f;
        for (int k = kq * 256; k < kq * 256 + 256; ++k) { const float w = W[(size_t)k * 6144];
#pragma unroll
            for (int r = 0; r < 9; ++r) a[r] += sc[r * 1024 + k] * w; }
#pragma unroll
        for (int r = 0; r < 9; ++r) red[(kq * 9 + r) * 128 + (F.tid & 127)] = a[r];
        __syncthreads();
        for (int i = F.tid; i < 9 * 128; i += NTHR) { const int r = i >> 7, cc = i & 127; const float v = red[(0 * 9 + r) * 128 + cc] + red[(1 * 9 + r) * 128 + cc] + red[(2 * 9 + r) * 128 + cc] + red[(3 * 9 + r) * 128 + cc];
            MOD[((size_t)layer * 9 + r) * 6144 + cb * 128 + cc] = v + ada_b[layer * 6144 + cb * 128 + cc]; }
        __syncthreads();
    }
}
__device__ __forceinline__ void rope_tables(Frame& F, f32x2* tabr, f32x2* tabm) {
    const int gt = F.vcu * NTHR + F.tid, NGT = F.G * NTHR;
    for (int i = gt; i < 64 * 64 + 64 * 16; i += NGT) {
        if (i < 4096) { const int pos = i >> 6, f = i & 63; const float inv = powf(10000.f, -(float)(2 * f) / 128.f); const float ang = (float)pos * inv; tabr[i] = (f32x2){cosf(ang), sinf(ang)}; }
        else { const int j = i - 4096, pos = j >> 4, f = j & 15; const float inv = powf(10000.f, -(float)(2 * f) / 32.f); const float ang = (float)pos * inv; tabm[j] = (f32x2){cosf(ang), sinf(ang)}; }
    }
}

__device__ __forceinline__ void norm_mod_row(const float* xrow, const float* g, const float* shift, const float* scale, bf16_t* orow, signed char* h8row, float* hsp, int lane) {
    const f32x4* xr = (const f32x4*)xrow + lane;
    f32x4 v[4]; float s = 0.f;
#pragma unroll
    for (int j = 0; j < 4; ++j) { v[j] = xr[64 * j]; s += (v[j].x * v[j].x + v[j].y * v[j].y) + (v[j].z * v[j].z + v[j].w * v[j].w); }
    const float rinv = rsqrtf(wave_sum(s) * (1.f / DM) + EPS);
#pragma unroll
    for (int j = 0; j < 4; ++j) {
        const f32x4 gg = ((const f32x4*)g)[lane + 64 * j], sh = ((const f32x4*)shift)[lane + 64 * j], sc = ((const f32x4*)scale)[lane + 64 * j];
        v[j].x = v[j].x * rinv * gg.x * (1.f + sc.x) + sh.x; v[j].y = v[j].y * rinv * gg.y * (1.f + sc.y) + sh.y;
        v[j].z = v[j].z * rinv * gg.z * (1.f + sc.z) + sh.z; v[j].w = v[j].w * rinv * gg.w * (1.f + sc.w) + sh.w;
        if (orow) ((unsigned long long*)orow)[lane + 64 * j] = (unsigned long long)cvt_pk_bf16(v[j].x, v[j].y) | ((unsigned long long)cvt_pk_bf16(v[j].z, v[j].w) << 32);
    }
    quant_row_store(v, h8row, hsp, lane);
}
__device__ __forceinline__ void norm_mod_row_b(const u32x4 (&xw)[2], const float* g, const float* shift, const float* scale, bf16_t* orow, signed char* h8row, float* hsp, int lane) {
    f32x4 v[4]; float s = 0.f;
#pragma unroll
    for (int j = 0; j < 2; ++j) { const u32x4 w = xw[j];
        v[2 * j] = (f32x4){bflo(w.x), bfhi(w.x), bflo(w.y), bfhi(w.y)}; v[2 * j + 1] = (f32x4){bflo(w.z), bfhi(w.z), bflo(w.w), bfhi(w.w)}; }
#pragma unroll
    for (int j = 0; j < 4; ++j) s += (v[j].x * v[j].x + v[j].y * v[j].y) + (v[j].z * v[j].z + v[j].w * v[j].w);
    const float rinv = rsqrtf(wave_sum(s) * (1.f / DM) + EPS);
    float m = 0.f;
#pragma unroll
    for (int j = 0; j < 4; ++j) { const int idx = 2 * (lane + 64 * (j >> 1)) + (j & 1);
        const f32x4 gg = ((const f32x4*)g)[idx], sh = ((const f32x4*)shift)[idx], sc = ((const f32x4*)scale)[idx];
        v[j] = v[j] * rinv * gg * (sc + 1.f) + sh;
        m = fmaxf(m, fmaxf(fmaxf(fabsf(v[j].x), fabsf(v[j].y)), fmaxf(fabsf(v[j].z), fabsf(v[j].w)))); }
#pragma unroll
    for (int j = 0; j < 2; ++j) { u32x4 w; w.x = cvt_pk_bf16(v[2 * j].x, v[2 * j].y); w.y = cvt_pk_bf16(v[2 * j].z, v[2 * j].w); w.z = cvt_pk_bf16(v[2 * j + 1].x, v[2 * j + 1].y); w.w = cvt_pk_bf16(v[2 * j + 1].z, v[2 * j + 1].w);
        ((u32x4*)orow)[lane + 64 * j] = w; }
    m = wave_max(m);
    const float qs = m > 0.f ? m * (1.f / 127.f) : 1.f, inv = 1.f / qs;
#pragma unroll
    for (int j = 0; j < 2; ++j) { u32x2 q; q.x = pack_i8x4(v[2 * j].x * inv, v[2 * j].y * inv, v[2 * j].z * inv, v[2 * j].w * inv); q.y = pack_i8x4(v[2 * j + 1].x * inv, v[2 * j + 1].y * inv, v[2 * j + 1].z * inv, v[2 * j + 1].w * inv);
        ((u32x2*)h8row)[lane + 64 * j] = q; }
    if (lane == 0) *hsp = qs;
}
__device__ __forceinline__ int mod_row_of(int r) { return r < NLAT ? (r >> 12) : 8; }

__device__ __forceinline__ void norm_router_block(Frame& F, int layer, int t0, int ntb, const bf16_t* XB, const float* g, const float* MODL, const bf16_t* Wr, signed char* H8, float* HS, float* LOGIT) {
    constexpr int HP = 2064;
    char* ldsg = (char*)F.lds;
    LAS unsigned char* HT = F.lds; LAS float* PT = (LAS float*)(F.lds + 36864);
    const int lane = F.lane, w = F.wave, l15 = lane & 15, q4 = lane >> 4;
    bf16x8 wreg[4][4];
#pragma unroll
    for (int nt = 0; nt < 4; ++nt)
#pragma unroll
        for (int ks = 0; ks < 4; ++ks) wreg[nt][ks] = *(const bf16x8*)(Wr + (size_t)(16 * nt + l15) * DM + 128 * w + 32 * ks + 8 * q4);
    for (int b0 = 0; b0 < ntb; b0 += 16) {
        u32x4 xw[2][2];
#pragma unroll
        for (int i = 0; i < 2; ++i) { const int rb = b0 + 2 * w + i; if (rb < ntb) { const bf16_t* xr = XB + (size_t)(t0 + rb) * DM; xw[i][0] = ((const u32x4*)xr)[lane]; xw[i][1] = ((const u32x4*)xr)[lane + 64]; } }
#pragma unroll
        for (int i = 0; i < 2; ++i) { const int rb = b0 + 2 * w + i; if (rb < ntb) { const int r = t0 + rb; const float* md = MODL + (size_t)mod_row_of(r) * 6144;
            norm_mod_row_b(xw[i], g, md + 3 * 1024, md + 4 * 1024, (bf16_t*)(ldsg + (2 * w + i) * HP), H8 + (size_t)r * DM, HS + r, lane); } }
        __syncthreads();
        f32x4 acc[4];
#pragma unroll
        for (int nt = 0; nt < 4; ++nt) acc[nt] = (f32x4){0.f, 0.f, 0.f, 0.f};
#pragma unroll
        for (int ks = 0; ks < 4; ++ks) { const bf16x8 hf = *(const LAS bf16x8*)(HT + l15 * HP + (128 * w + 32 * ks + 8 * q4) * 2);
#pragma unroll
            for (int nt = 0; nt < 4; ++nt) acc[nt] = __builtin_amdgcn_mfma_f32_16x16x32_bf16(wreg[nt][ks], hf, acc[nt], 0, 0, 0); }
#pragma unroll
        for (int nt = 0; nt < 4; ++nt) *(LAS f32x4*)(PT + (w * 16 + l15) * 64 + 16 * nt + 4 * q4) = acc[nt];
        __syncthreads();
        { const int row = F.tid >> 5, e2 = (F.tid & 31) * 2; f32x2 s = (f32x2){0.f, 0.f};
#pragma unroll
          for (int ww = 0; ww < 8; ++ww) { const f32x2 p = *(const LAS f32x2*)(PT + (ww * 16 + row) * 64 + e2); s.x += p.x; s.y += p.y; }
          if (b0 + row < ntb) *(f32x2*)(LOGIT + (size_t)(t0 + b0 + row) * 64 + e2) = s; }
    }
    __syncthreads();
}


struct EpiRetProj {
    static constexpr int PERM = 2;
    bf16_t* QK; bf16_t* V; bf16_t* Gt; const f32x4* tab;
    __device__ __forceinline__ void operator()(const f32x4 (&acc)[2][2][4][2], const g8::Unit& u, int wr, int wc, int fr, int fq) const {
        const int col0 = u.col0; bf16_t* base; int ldc, cc;
        if (col0 < 2048) { base = QK; ldc = 2048; cc = col0; } else if (col0 < 4096) { base = V; ldc = 2048; cc = col0 - 2048; } else { base = Gt; ldc = 4096; cc = col0 - 4096; }
        const bool isqk = col0 < 2048, rope = isqk && (u.row0 < NLAT);
        const float sc = (col0 >= 1024 && col0 < 2048) ? 0.0625f : 1.f;
        const int axis = wc >> 1, i0 = (64 * (wc & 1) + 16 * fq) >> 1;
#pragma unroll
        for (int ai = 0; ai < 2; ++ai)
#pragma unroll
            for (int m = 0; m < 4; ++m) {
                const int r = u.row0 + ai * 128 + wr * 64 + m * 16 + fr;
                bf16_t* rowp = base + (size_t)r * ldc + cc + wc * 64 + 16 * fq;
                const int s = r & 4095;
                u32x4 w[2];
#pragma unroll
                for (int bj = 0; bj < 2; ++bj) {
                    f32x4 v0 = acc[ai][bj][m][0], v1 = acc[ai][bj][m][1];
                    if (rope) {
                        const int pos = axis == 0 ? (s >> 6) : (s & 63);
                        const f32x4* tp = tab + ((pos * 64 + i0 + 4 * bj) >> 1);
                        const f32x4 t0 = tp[0], t1 = tp[1];
                        f32x4 o0, o1;
                        o0.x = v0.x * t0.x - v0.y * t0.y; o0.y = v0.y * t0.x + v0.x * t0.y; o0.z = v0.z * t0.z - v0.w * t0.w; o0.w = v0.w * t0.z + v0.z * t0.w;
                        o1.x = v1.x * t1.x - v1.y * t1.y; o1.y = v1.y * t1.x + v1.x * t1.y; o1.z = v1.z * t1.z - v1.w * t1.w; o1.w = v1.w * t1.z + v1.z * t1.w;
                        v0 = o0; v1 = o1;
                    }
                    v0 = v0 * sc; v1 = v1 * sc;
                    w[bj].x = cvt_pk_bf16(v0.x, v0.y); w[bj].y = cvt_pk_bf16(v0.z, v0.w); w[bj].z = cvt_pk_bf16(v1.x, v1.y); w[bj].w = cvt_pk_bf16(v1.z, v1.w);
                }
                if (col0 < 4096) { *(u32x4*)rowp = w[0]; *(u32x4*)(rowp + 8) = w[1]; }
                else {
                    u32x4 g8;
#pragma unroll
                    for (int bj = 0; bj < 2; ++bj)
#pragma unroll
                        for (int n = 0; n < 2; ++n) { f32x4 v = acc[ai][bj][m][n];
#pragma unroll
                            for (int j = 0; j < 4; ++j) v[j] = __builtin_amdgcn_fmed3f(v[j], -448.f, 448.f);
                            int p = 0; p = __builtin_amdgcn_cvt_pk_fp8_f32(v.x, v.y, p, false); p = __builtin_amdgcn_cvt_pk_fp8_f32(v.z, v.w, p, true); g8[bj * 2 + n] = (unsigned)p; }
                    *(u32x4*)((unsigned char*)Gt + (size_t)r * 4096 + cc + wc * 64 + 16 * fq) = g8;
                }
            }
    }
};
template <bool INBF> struct EpiResid {
    static constexpr int PERM = 1;
    const float* xin_l; const float* xin_c; bf16_t* xb; const float* gate;
    __device__ __forceinline__ void operator()(const f32x4 (&acc)[2][2][4][2], const g8::Unit& u, int wr, int wc, int fr, int fq) const {
        const bool lat = u.row0 < NLAT;
        const int cofs = u.col0 + wc * 32 + 8 * fq;
        const float* gin = gate + (size_t)(lat ? (u.row0 >> 12) : 8) * 6144 + cofs;
        f32x4 gv[2][2];
#pragma unroll
        for (int bj = 0; bj < 2; ++bj)
#pragma unroll
            for (int n = 0; n < 2; ++n) gv[bj][n] = *(const f32x4*)(gin + bj * 128 + n * 4);
#pragma unroll
        for (int ai = 0; ai < 2; ++ai)
#pragma unroll
            for (int m = 0; m < 4; ++m) {
                const int r = u.row0 + ai * 128 + wr * 64 + m * 16 + fr;
                bf16_t* op = xb + (size_t)r * DM + cofs;
                const float* ip = (lat ? xin_l + (size_t)r * DM : xin_c + (size_t)(r - NLAT) * DM) + cofs;
#pragma unroll
                for (int bj = 0; bj < 2; ++bj) {
                    f32x4 x0, x1;
                    if constexpr (INBF) { const u32x4 w = *(const u32x4*)(op + bj * 128); x0 = (f32x4){bflo(w.x), bfhi(w.x), bflo(w.y), bfhi(w.y)}; x1 = (f32x4){bflo(w.z), bfhi(w.z), bflo(w.w), bfhi(w.w)}; }
                    else { x0 = *(const f32x4*)(ip + bj * 128); x1 = *(const f32x4*)(ip + bj * 128 + 4); }
                    x0 += gv[bj][0] * acc[ai][bj][m][0]; x1 += gv[bj][1] * acc[ai][bj][m][1];
                    u32x4 w; w.x = cvt_pk_bf16(x0.x, x0.y); w.y = cvt_pk_bf16(x0.z, x0.w); w.z = cvt_pk_bf16(x1.x, x1.y); w.w = cvt_pk_bf16(x1.z, x1.w);
                    *(u32x4*)(op + bj * 128) = w; }
            }
    }
};

struct EpiLogits {
    static constexpr int PERM = 0;
    float* L;
    __device__ __forceinline__ void operator()(const f32x4 (&acc)[2][2][4][2], const g8::Unit& u, int wr, int wc, int fr, int fq) const {
        if (wc >= 2) return;
#pragma unroll
        for (int ai = 0; ai < 2; ++ai)
#pragma unroll
            for (int m = 0; m < 4; ++m) { float* rp = L + (size_t)(u.row0 + ai * 128 + wr * 64 + m * 16 + fr) * 64 + wc * 32 + 4 * fq;
#pragma unroll
                for (int n = 0; n < 2; ++n) *(f32x4*)(rp + n * 16) = acc[ai][0][m][n]; }
    }
};
struct EpiAct {
    static constexpr int PERM = 1;
    bf16_t* ACT;
    __device__ __forceinline__ void operator()(const f32x4 (&acc)[2][2][4][2], const g8::Unit& u, int wr, int wc, int fr, int fq) const {
#pragma unroll
        for (int ai = 0; ai < 2; ++ai)
#pragma unroll
            for (int m = 0; m < 4; ++m) {
                bf16_t* rp = ACT + (size_t)(u.row0 + ai * 128 + wr * 64 + m * 16 + fr) * 256 + (u.col0 >> 1) + wc * 32 + 8 * fq;
                const f32x4 g0 = acc[ai][0][m][0], g1 = acc[ai][0][m][1], u0 = acc[ai][1][m][0], u1 = acc[ai][1][m][1];
                u32x4 w; w.x = cvt_pk_bf16(siluf(g0.x) * u0.x, siluf(g0.y) * u0.y); w.y = cvt_pk_bf16(siluf(g0.z) * u0.z, siluf(g0.w) * u0.w);
                w.z = cvt_pk_bf16(siluf(g1.x) * u1.x, siluf(g1.y) * u1.y); w.w = cvt_pk_bf16(siluf(g1.z) * u1.z, siluf(g1.w) * u1.w);
                *(u32x4*)rp = w;
            }
    }
};
constexpr float YS_SCALE = 32.f;
struct EpiDown {
    static constexpr int PERM = 2;
    unsigned char* YS;
    __device__ __forceinline__ void operator()(const f32x4 (&acc)[2][2][4][2], const g8::Unit& u, int wr, int wc, int fr, int fq) const {
#pragma unroll
        for (int ai = 0; ai < 2; ++ai)
#pragma unroll
            for (int m = 0; m < 4; ++m) {
                const int r = ai * 128 + wr * 64 + m * 16 + fr;
                const float wt = YS_SCALE;
                u32x4 w;
#pragma unroll
                for (int bj = 0; bj < 2; ++bj)
#pragma unroll
                    for (int n = 0; n < 2; ++n) { f32x4 v = acc[ai][bj][m][n] * wt;
#pragma unroll
                        for (int j = 0; j < 4; ++j) v[j] = __builtin_amdgcn_fmed3f(v[j], -448.f, 448.f);
                        int p = 0; p = __builtin_amdgcn_cvt_pk_fp8_f32(v.x, v.y, p, false); p = __builtin_amdgcn_cvt_pk_fp8_f32(v.z, v.w, p, true); w[bj * 2 + n] = (unsigned)p; }
                *(u32x4*)(YS + (size_t)(u.row0 + r) * 1024 + u.col0 + wc * 64 + 16 * fq) = w;
            }
    }
};

namespace g8 { template <> struct epi_nst<EpiRetProj> { static constexpr int value = 8; }; template <bool B> struct epi_nst<EpiResid<B>> { static constexpr int value = 16; };
               template <> struct epi_nst<EpiAct> { static constexpr int value = 8; }; template <> struct epi_nst<EpiDown> { static constexpr int value = 8; }; }

constexpr int LDS_TPRE = LDSCTL_OFF + 1024, LDS_CNTS = LDSCTL_OFF + 2048;
__device__ __forceinline__ void build_tpre(Frame& F, int layer, int ntok) {
    LAS int* tpre = (LAS int*)(F.lds + LDS_TPRE); LAS int* cnts = (LAS int*)(F.lds + LDS_CNTS);
    __syncthreads();
    if (F.tid < 64) {
        const int cn = (int)__hip_atomic_load(F.ctl + CW_CNT + (layer * 64 + F.tid) * 16, __ATOMIC_RELAXED, __HIP_MEMORY_SCOPE_AGENT);
        int t = (cn + 255) >> 8, inc = t;
#pragma unroll
        for (int o = 1; o < 64; o <<= 1) { const int v = __shfl_up(inc, o); if (F.lane >= o) inc += v; }
        cnts[F.tid] = cn; tpre[F.tid + 1] = inc; if (F.tid == 0) tpre[0] = 0;
        if (F.tid == 63) { cnts[64] = ntok; tpre[65] = inc + (ntok >> 8); }
    }
    __syncthreads();
}
__device__ __forceinline__ void route_block(Frame& F, int layer, int t0, int ntb, const float* logits, const float* bias, int* LIST, float* RTW, int* RTP, const float* HS, float* LISTS) {
    LAS int* lcnt = (LAS int*)F.lds; LAS int* gbase = lcnt + 64; LAS int* rec_e = lcnt + 128; LAS float* rec_w = (LAS float*)(rec_e + 2048);
    const int lane = F.lane;
    if (F.tid < 64) lcnt[F.tid] = 0;
    __syncthreads();
    const float bl = bias[lane];
    for (int tl0 = F.wave; tl0 < ntb; tl0 += 4 * NWAVES) {
        constexpr int TT = 4;
        float s[TT], sel[TT], m1[TT], m2[TT], gs[TT], v[TT], ssum[TT]; int i1[TT], grank[TT], rank[TT]; bool ok[TT];
#pragma unroll
        for (int u = 0; u < TT; ++u) { const int tl = tl0 + u * NWAVES; ok[u] = tl < ntb; const int tq = ok[u] ? tl : tl0;
            s[u] = __builtin_amdgcn_rcpf(1.f + __expf(-logits[(size_t)(t0 + tq) * 64 + lane])); sel[u] = s[u] + bl; m1[u] = sel[u]; }
#pragma unroll
        for (int o = 1; o < 8; o <<= 1)
#pragma unroll
            for (int u = 0; u < TT; ++u) m1[u] = fmaxf(m1[u], __shfl_xor(m1[u], o));
#pragma unroll
        for (int u = 0; u < TT; ++u) i1[u] = (sel[u] == m1[u]) ? lane : 64;
#pragma unroll
        for (int o = 1; o < 8; o <<= 1)
#pragma unroll
            for (int u = 0; u < TT; ++u) i1[u] = min(i1[u], __shfl_xor(i1[u], o));
#pragma unroll
        for (int u = 0; u < TT; ++u) m2[u] = (lane == i1[u]) ? -INFINITY : sel[u];
#pragma unroll
        for (int o = 1; o < 8; o <<= 1)
#pragma unroll
            for (int u = 0; u < TT; ++u) m2[u] = fmaxf(m2[u], __shfl_xor(m2[u], o));
        const int g = lane >> 3;
#pragma unroll
        for (int u = 0; u < TT; ++u) { gs[u] = m1[u] + m2[u]; grank[u] = 0; }
#pragma unroll
        for (int gg = 0; gg < 8; ++gg)
#pragma unroll
            for (int u = 0; u < TT; ++u) { const float o = __builtin_bit_cast(float, __builtin_amdgcn_readlane(__builtin_bit_cast(int, gs[u]), gg * 8)); grank[u] += (o > gs[u] || (o == gs[u] && gg < g)) ? 1 : 0; }
#pragma unroll
        for (int u = 0; u < TT; ++u) { v[u] = grank[u] < 4 ? sel[u] : -INFINITY; rank[u] = 0; }
#pragma unroll
        for (int l = 0; l < 64; ++l)
#pragma unroll
            for (int u = 0; u < TT; ++u) { const float o = __builtin_bit_cast(float, __builtin_amdgcn_readlane(__builtin_bit_cast(int, v[u]), l)); rank[u] += (o > v[u] || (o == v[u] && l < lane)) ? 1 : 0; }
#pragma unroll
        for (int u = 0; u < TT; ++u) ssum[u] = (rank[u] < 8) ? s[u] : 0.f;
#pragma unroll
        for (int o = 1; o < 64; o <<= 1)
#pragma unroll
            for (int u = 0; u < TT; ++u) ssum[u] += __shfl_xor(ssum[u], o);
#pragma unroll
        for (int u = 0; u < TT; ++u) {
            if (ok[u] && rank[u] < 8) { const int tl = tl0 + u * NWAVES;
                const int lp = __hip_atomic_fetch_add(lcnt + lane, 1, __ATOMIC_RELAXED, __HIP_MEMORY_SCOPE_WORKGROUP);
                rec_e[tl * 8 + rank[u]] = (lane << 20) | lp; rec_w[tl * 8 + rank[u]] = s[u] / ssum[u] * 2.5f; }
        }
    }
    __syncthreads();
    if (F.tid < 64) gbase[F.tid] = (int)__hip_atomic_fetch_add(F.ctl + CW_CNT + (layer * 64 + F.tid) * 16, (unsigned)lcnt[F.tid], __ATOMIC_RELAXED, __HIP_MEMORY_SCOPE_AGENT);
    __syncthreads();
    for (int i = F.tid; i < ntb * 8; i += NTHR) {
        const int el = rec_e[i], e = el >> 20, p = gbase[e] + (el & 0xfffff), t = t0 + (i >> 3);
        LIST[(size_t)e * NT + p] = t; LISTS[(size_t)e * NT + p] = HS[t]; RTP[(size_t)t * 8 + (i & 7)] = (e << 20) | p; RTW[(size_t)t * 8 + (i & 7)] = rec_w[i];
    }
    __syncthreads();
}
template <bool OUTF32> __device__ __forceinline__ void combine_row(Frame& F, const int* RTP, const float* RTW, int t, const unsigned char* YS, const bf16_t* xrow, float* xof, bf16_t* xob, const float* gate, bool donorm, const float* g, const float* shift, const float* scale, signed char* h8row, float* hsp) {
    const LAS int* tpre = (const LAS int*)(F.lds + LDS_TPRE);
    const int lane = F.lane;
    int ep[8];
#pragma unroll
    for (int k = 0; k < 8; ++k) ep[k] = RTP[(size_t)t * 8 + k];
    u32x4 yv[9];
#pragma unroll
    for (int k = 0; k < 9; ++k) {
        const size_t pos = k < 8 ? (size_t)tpre[ep[k < 8 ? k : 0] >> 20] * 256 + (ep[k < 8 ? k : 0] & 0xfffff) : (size_t)tpre[64] * 256 + t;
        yv[k] = *(const u32x4*)(YS + pos * 1024 + 16 * lane);
    }
    f32x4 xi[4];
#pragma unroll
    for (int j = 0; j < 2; ++j) { const u32x4 w = ((const u32x4*)xrow)[2 * lane + j];
        xi[2 * j] = (f32x4){bflo(w.x), bfhi(w.x), bflo(w.y), bfhi(w.y)}; xi[2 * j + 1] = (f32x4){bflo(w.z), bfhi(w.z), bflo(w.w), bfhi(w.w)}; }
    f32x4 a[4];
#pragma unroll
    for (int j = 0; j < 4; ++j) a[j] = (f32x4){0.f, 0.f, 0.f, 0.f};
#pragma unroll
    for (int k = 0; k < 9; ++k) { const float wk = k < 8 ? RTW[(size_t)t * 8 + (k < 8 ? k : 0)] : 1.f;
#pragma unroll
        for (int j = 0; j < 4; ++j) { const f32x2 lo = __builtin_amdgcn_cvt_pk_f32_fp8((int)yv[k][j], false), hi = __builtin_amdgcn_cvt_pk_f32_fp8((int)yv[k][j], true);
            a[j].x += wk * lo.x; a[j].y += wk * lo.y; a[j].z += wk * hi.x; a[j].w += wk * hi.y; } }
    f32x4 v[4]; float ss = 0.f;
#pragma unroll
    for (int j = 0; j < 4; ++j) { const f32x4 gg = *(const f32x4*)(gate + 16 * lane + 4 * j);
        v[j] = xi[j] + gg * a[j] * (1.f / YS_SCALE);
        if constexpr (OUTF32) *(f32x4*)(xof + 16 * lane + 4 * j) = v[j];
        ss += (v[j].x * v[j].x + v[j].y * v[j].y) + (v[j].z * v[j].z + v[j].w * v[j].w); }
    if constexpr (!OUTF32) {
#pragma unroll
        for (int j = 0; j < 2; ++j) { u32x4 w; w.x = cvt_pk_bf16(v[2 * j].x, v[2 * j].y); w.y = cvt_pk_bf16(v[2 * j].z, v[2 * j].w); w.z = cvt_pk_bf16(v[2 * j + 1].x, v[2 * j + 1].y); w.w = cvt_pk_bf16(v[2 * j + 1].z, v[2 * j + 1].w);
            ((u32x4*)xob)[2 * lane + j] = w; }
    }
    if (donorm) {
        const float rinv = rsqrtf(wave_sum(ss) * (1.f / DM) + EPS);
        float m = 0.f;
#pragma unroll
        for (int j = 0; j < 4; ++j) {
            const f32x4 gg = *(const f32x4*)(g + 16 * lane + 4 * j), sh = *(const f32x4*)(shift + 16 * lane + 4 * j), sc = *(const f32x4*)(scale + 16 * lane + 4 * j);
            v[j] = v[j] * rinv * gg * (sc + 1.f) + sh;
            m = fmaxf(m, fmaxf(fmaxf(fabsf(v[j].x), fabsf(v[j].y)), fmaxf(fabsf(v[j].z), fabsf(v[j].w))));
        }
        m = wave_max(m);
        const float qs = m > 0.f ? m * (1.f / 127.f) : 1.f, inv = 1.f / qs;
        u32x4 q;
#pragma unroll
        for (int j = 0; j < 4; ++j) q[j] = pack_i8x4(v[j].x * inv, v[j].y * inv, v[j].z * inv, v[j].w * inv);
        *(u32x4*)(h8row + 16 * lane) = q;
        if (lane == 0) *hsp = qs;
    }
}

struct EpiStore {
    static constexpr int PERM = 1;
    bf16_t* O; int ldc;
    __device__ __forceinline__ void operator()(const f32x4 (&acc)[2][2][4][2], const g8::Unit& u, int wr, int wc, int fr, int fq) const {
#pragma unroll
        for (int ai = 0; ai < 2; ++ai)
#pragma unroll
            for (int m = 0; m < 4; ++m) {
                bf16_t* rp = O + (size_t)(u.row0 + ai * 128 + wr * 64 + m * 16 + fr) * ldc + u.col0 + wc * 32 + 8 * fq;
#pragma unroll
                for (int bj = 0; bj < 2; ++bj) { const f32x4 v0 = acc[ai][bj][m][0], v1 = acc[ai][bj][m][1];
                    u32x4 w; w.x = cvt_pk_bf16(v0.x, v0.y); w.y = cvt_pk_bf16(v0.z, v0.w); w.z = cvt_pk_bf16(v1.x, v1.y); w.w = cvt_pk_bf16(v1.z, v1.w);
                    *(u32x4*)(rp + bj * 128) = w; }
            }
    }
};

namespace g8 { template <> struct epi_nst<EpiStore> { static constexpr int value = 16; }; }

__device__ __forceinline__ void mla_final_row(int r, const bf16_t* A, const bf16_t* QRAW, const bf16_t* KVRAW, const float* qnorm, const float* knorm, const f32x2* tabm, signed char* QF, signed char* KF, bf16_t* VF, int lane) {
    const bool lat = r < NLAT;
    const int b = lat ? (r >> 12) : ((r - NLAT) >> 8), s = lat ? (r & 4095) : 0, kidx = lat ? s : 4096 + ((r - NLAT) & 255);
    constexpr float QKS = 127.f / 8.f;
    unsigned qw[8], kw[8], vw[8], aq[3]; bf16_t qrp[8];
    const bf16_t* kvr = KVRAW + (size_t)r * 2048; const bf16_t* ar = A + (size_t)r * 768;
#pragma unroll
    for (int h = 0; h < 8; ++h) { kw[h] = *(const unsigned*)(kvr + h * 256 + 2 * lane); vw[h] = *(const unsigned*)(kvr + h * 256 + 128 + 2 * lane); }
    const u32x2 akv = *(const u32x2*)(ar + 384 + 4 * lane); const float akr = bf2f(ar[640 + lane]);
    if (lat) {
        const bf16_t* qrw = QRAW + (size_t)r * 1536;
#pragma unroll
        for (int h = 0; h < 8; ++h) { qw[h] = *(const unsigned*)(qrw + h * 192 + 2 * lane); qrp[h] = qrw[h * 192 + 128 + lane]; }
#pragma unroll
        for (int j = 0; j < 3; ++j) aq[j] = *(const unsigned*)(ar + 128 * j + 2 * lane);
    }
    const f32x2 gq = *(const f32x2*)(qnorm + 2 * lane), gk = *(const f32x2*)(knorm + 2 * lane); const float gqr = qnorm[128 + lane], gkr = knorm[128 + lane];
    const int a = lane >> 5, t = (lane >> 4) & 1, i = lane & 15, pos = a == 0 ? (s >> 6) : (s & 63);
    const f32x2 cs = tabm[pos * 16 + i];
    float sk[8], sq[8], sr[8];
    float skv = bflo(akv.x) * bflo(akv.x) + bfhi(akv.x) * bfhi(akv.x) + bflo(akv.y) * bflo(akv.y) + bfhi(akv.y) * bfhi(akv.y), skr = akr * akr, saq = 0.f;
#pragma unroll
    for (int h = 0; h < 8; ++h) { const float k0 = bflo(kw[h]), k1 = bfhi(kw[h]); sk[h] = k0 * k0 + k1 * k1; }
    if (lat) {
#pragma unroll
        for (int h = 0; h < 8; ++h) { const float q0 = bflo(qw[h]), q1 = bfhi(qw[h]), qr_ = bf2f(qrp[h]); sq[h] = q0 * q0 + q1 * q1; sr[h] = qr_ * qr_; }
#pragma unroll
        for (int j = 0; j < 3; ++j) saq += bflo(aq[j]) * bflo(aq[j]) + bfhi(aq[j]) * bfhi(aq[j]);
    }
#pragma unroll
    for (int o = 1; o < 64; o <<= 1) {
#pragma unroll
        for (int h = 0; h < 8; ++h) sk[h] += __shfl_xor(sk[h], o);
        skv += __shfl_xor(skv, o); skr += __shfl_xor(skr, o);
        if (lat) {
#pragma unroll
            for (int h = 0; h < 8; ++h) { sq[h] += __shfl_xor(sq[h], o); sr[h] += __shfl_xor(sr[h], o); }
            saq += __shfl_xor(saq, o);
        }
    }
    const float rkv = rsqrtf(skv * (1.f / 256.f) + EPS), rkv2 = rkv * rkv;
    const float rqa = lat ? rsqrtf(saq * (1.f / 384.f) + EPS) : 1.f, rqa2 = rqa * rqa;
    float krn = akr * rsqrtf(skr * (1.f / 64.f) + EPS) * gkr;
    { const float pr = __shfl_xor(krn, 16); if (lat) krn = krn * cs.x + (t ? pr * cs.y : -pr * cs.y); }
    const int kr8 = (int)rintf(__builtin_amdgcn_fmed3f(krn * QKS, -127.f, 127.f));
#pragma unroll
    for (int h = 0; h < 8; ++h) {
        const size_t kvo = (size_t)(b * 8 + h) * SKV + kidx;
        const float rinv = rkv * rsqrtf(rkv2 * sk[h] * (1.f / 128.f) + EPS) * QKS;
        signed char* ko = KF + kvo * 192;
        { const int k0 = (int)rintf(__builtin_amdgcn_fmed3f(bflo(kw[h]) * rinv * gk.x, -127.f, 127.f)), k1 = (int)rintf(__builtin_amdgcn_fmed3f(bfhi(kw[h]) * rinv * gk.y, -127.f, 127.f));
          *(unsigned short*)(ko + 2 * lane) = (unsigned short)((k0 & 255) | ((k1 & 255) << 8)); }
        ko[128 + lane] = (signed char)kr8;
        *(unsigned*)(VF + kvo * 128 + 2 * lane) = cvt_pk_bf16(bflo(vw[h]) * rkv, bfhi(vw[h]) * rkv);
        if (lat) {
            const float rq = rqa * rsqrtf(rqa2 * sq[h] * (1.f / 128.f) + EPS) * QKS, rr = rqa * rsqrtf(rqa2 * sr[h] * (1.f / 64.f) + EPS);
            signed char* qo = QF + ((size_t)(b * 8 + h) * 4096 + s) * 192;
            { const int q0 = (int)rintf(__builtin_amdgcn_fmed3f(bflo(qw[h]) * rq * gq.x, -127.f, 127.f)), q1 = (int)rintf(__builtin_amdgcn_fmed3f(bfhi(qw[h]) * rq * gq.y, -127.f, 127.f));
              *(unsigned short*)(qo + 2 * lane) = (unsigned short)((q0 & 255) | ((q1 & 255) << 8)); }
            float vn = bf2f(qrp[h]) * rr * gqr; const float pr = __shfl_xor(vn, 16);
            vn = vn * cs.x + (t ? pr * cs.y : -pr * cs.y);
            qo[128 + lane] = (signed char)(int)rintf(__builtin_amdgcn_fmed3f(vn * QKS, -127.f, 127.f));
        }
    }
}

namespace att {
constexpr int NW = 8, QBLK = 32, KVBLK = 64, DQ = 192, DV = 128;
constexpr int KROW = 208;
constexpr int SHM_V = KVBLK * DV * 2, SHM_K = KVBLK * KROW;
constexpr int K_OFF = 3 * SHM_V, WS_OFF = K_OFF + 3 * SHM_K;
constexpr float THRL = 11.5f;
constexpr float SC = 0.07216878364870322f * 1.4426950408889634f / (15.875f * 15.875f);
constexpr float MAGIC = 12582912.f;
typedef int i32x16 __attribute__((ext_vector_type(16)));
#define SBAR() __builtin_amdgcn_sched_barrier(0)
#define MF8(A, B, C) __builtin_amdgcn_mfma_i32_32x32x32_i8((A), (B), (C), 0, 0, 0)
#define MFB(A, B, C) __builtin_amdgcn_mfma_f32_32x32x16_bf16((A), (B), (C), 0, 0, 0)
#define EX2(x) __builtin_amdgcn_exp2f(x)
__device__ __forceinline__ int crow(int r, int hi) { return (r & 3) + 8 * (r >> 2) + 4 * hi; }
__device__ __forceinline__ int v_st(int k, int c) { const int kk = (k & ~0xC) | ((k & 4) << 1) | ((k & 8) >> 1); return ((kk >> 3) * 4 + (c >> 5)) * 512 + ((kk & 7) * 32 + (c & 31)) * 2; }
__device__ __forceinline__ int v_rd_base(int lane) { return ((lane & 3) << 3) | (((lane >> 2) & 3) << 6) | (((lane >> 4) & 1) << 5) | (((lane >> 5) & 1) << 8); }
constexpr int v_rd_off(int d0, int ks, int half) { return d0 * 512 + ks * 4096 + half * 2048; }
typedef short v4i16_t __attribute__((ext_vector_type(4)));
__device__ __forceinline__ bf16x8 vfrag(const LAS unsigned char* p, int off) {
    const s16x4 l = __builtin_bit_cast(s16x4, __builtin_amdgcn_ds_read_tr16_b64_v4i16((LAS v4i16_t*)(p + off)));
    const s16x4 h = __builtin_bit_cast(s16x4, __builtin_amdgcn_ds_read_tr16_b64_v4i16((LAS v4i16_t*)(p + off + 2048)));
    return (bf16x8){l[0], l[1], l[2], l[3], h[0], h[1], h[2], h[3]};
}
#define EXP4(P, R) do { P[R] = EX2(P[R]); P[(R) + 1] = EX2(P[(R) + 1]); P[(R) + 2] = EX2(P[(R) + 2]); P[(R) + 3] = EX2(P[(R) + 3]); } while (0)
#define EXP3(P, R) do { P[R] = EX2(P[R]); P[(R) + 1] = EX2(P[(R) + 1]); P[(R) + 2] = EX2(P[(R) + 2]); } while (0)
#define ADD8(P, R) do { ps += P[R]; pt += P[(R) + 1]; ps += P[(R) + 2]; pt += P[(R) + 3]; ps += P[(R) + 4]; pt += P[(R) + 5]; ps += P[(R) + 6]; pt += P[(R) + 7]; } while (0)
#define MAX8(P, R) do { pm = fmaxf(fmaxf(pm, P[R]), P[(R) + 1]); pn = fmaxf(fmaxf(pn, P[(R) + 2]), P[(R) + 3]); pm = fmaxf(fmaxf(pm, P[(R) + 4]), P[(R) + 5]); pn = fmaxf(fmaxf(pn, P[(R) + 6]), P[(R) + 7]); } while (0)
#define FMA8(P, R) do { _Pragma("unroll") for (int _r = 0; _r < 8; ++_r) P[(R) + _r] = fmaf(P[(R) + _r], SC, mc); } while (0)
#define PK4(P, BASE, OUT) do { unsigned a0_ = cvt_pk_bf16(P[BASE + 0], P[BASE + 1]), a1_ = cvt_pk_bf16(P[BASE + 2], P[BASE + 3]);   \
    unsigned b0_ = cvt_pk_bf16(P[BASE + 4], P[BASE + 5]), b1_ = cvt_pk_bf16(P[BASE + 6], P[BASE + 7]);                              \
    auto r0_ = __builtin_amdgcn_permlane32_swap(a0_, b0_, false, false); auto r1_ = __builtin_amdgcn_permlane32_swap(a1_, b1_, false, false); \
    u32x4 w_ = {r0_[0], r1_[0], r0_[1], r1_[1]}; OUT = __builtin_bit_cast(bf16x8, w_); } while (0)
__device__ __forceinline__ void region1(f32x16& Y0, f32x16& Y1, f32x16& X0, f32x16& X1, float alX, float& l_reg, bf16x8& pa0, bf16x8& pa1, bf16x8& pa2, bf16x8& pa3,
                                        const char* kb, const i32x4* qr, const i32x16& mg) {
#define KF(i) (*reinterpret_cast<const i32x4*>(kb + ((i) & 1) * 32 * KROW + ((i) >> 1) * 32))
    i32x16 a0, a1; i32x4 f0 = KF(0), f1 = KF(1), f2 = KF(2);
    float ps = 0.f, pt = 0.f;
    EXP4(X1, 0); EXP4(X1, 4); SBAR();
    a0 = MF8(f0, qr[0], mg); f0 = KF(3); EXP4(X1, 8); SBAR();
    a1 = MF8(f1, qr[0], mg); f1 = KF(4); EXP4(X1, 12); SBAR();
    a0 = MF8(f2, qr[1], a0); f2 = KF(5); ADD8(X0, 0); SBAR();
    a1 = MF8(f0, qr[1], a1); f0 = KF(6); ADD8(X0, 8); SBAR();
    a0 = MF8(f1, qr[2], a0); f1 = KF(7); ADD8(X1, 0); SBAR();
    a1 = MF8(f2, qr[2], a1); f2 = KF(8); ADD8(X1, 8); SBAR();
    a0 = MF8(f0, qr[3], a0); f0 = KF(9);
    { ps += pt; auto rr = __builtin_amdgcn_permlane32_swap(__float_as_uint(ps), __float_as_uint(ps), false, false); ps = __uint_as_float(rr[0]) + __uint_as_float(rr[1]); l_reg = l_reg * alX + ps; }
    SBAR();
    a1 = MF8(f1, qr[3], a1); f1 = KF(10); PK4(X0, 0, pa0); SBAR();
    a0 = MF8(f2, qr[4], a0); f2 = KF(11); PK4(X0, 8, pa1); SBAR();
    a1 = MF8(f0, qr[4], a1); PK4(X1, 0, pa2); SBAR();
    a0 = MF8(f1, qr[5], a0); PK4(X1, 8, pa3); SBAR();
    a1 = MF8(f2, qr[5], a1); SBAR();
    Y0 = __builtin_bit_cast(f32x16, a0); Y1 = __builtin_bit_cast(f32x16, a1);
#undef KF
}
__device__ __forceinline__ void region2(f32x16* o, f32x16& Y0, f32x16& Y1, float& m_reg, float& alY, bf16x8 pa0, bf16x8 pa1, bf16x8 pa2, bf16x8 pa3, const LAS unsigned char* vp) {
#define VF(n) vfrag(vp, v_rd_off((((n) >> 3) << 1) | ((n) & 1), ((n) >> 1) & 3, 0))
    bf16x8 g0 = VF(0), g1 = VF(1), g2 = VF(2);
    float pm = Y0[0], pn = Y0[1], mc;
    SBAR();
    o[0] = MFB(pa0, g0, o[0]); g0 = VF(3); MAX8(Y0, 0); SBAR();
    o[1] = MFB(pa0, g1, o[1]); g1 = VF(4); MAX8(Y0, 8); SBAR();
    o[0] = MFB(pa1, g2, o[0]); g2 = VF(5); MAX8(Y1, 0); SBAR();
    o[1] = MFB(pa1, g0, o[1]); g0 = VF(6); MAX8(Y1, 8); SBAR();
    o[0] = MFB(pa2, g1, o[0]); g1 = VF(7);
    { pm = fmaxf(pm, pn); auto rr = __builtin_amdgcn_permlane32_swap(__float_as_uint(pm), __float_as_uint(pm), false, false); pm = fmaxf(__uint_as_float(rr[0]), __uint_as_float(rr[1])); pm = (pm - MAGIC) * SC; }
    SBAR();
    o[1] = MFB(pa2, g2, o[1]); g2 = VF(8);
    { const bool ok = __all(pm - m_reg <= THRL); const float mn = ok ? m_reg : fmaxf(m_reg, pm); alY = EX2(m_reg - mn); m_reg = mn; mc = -(mn + MAGIC * SC); }
    SBAR();
    o[0] = MFB(pa3, g0, o[0]); g0 = VF(9); FMA8(Y0, 0); SBAR();
    o[1] = MFB(pa3, g1, o[1]); g1 = VF(10); FMA8(Y0, 8); SBAR();
    o[2] = MFB(pa0, g2, o[2]); g2 = VF(11); FMA8(Y1, 0); SBAR();
    o[3] = MFB(pa0, g0, o[3]); g0 = VF(12); FMA8(Y1, 8); SBAR();
    o[2] = MFB(pa1, g1, o[2]); g1 = VF(13); EXP3(Y0, 0); SBAR();
    o[3] = MFB(pa1, g2, o[3]); g2 = VF(14); EXP3(Y0, 3); SBAR();
    o[2] = MFB(pa2, g0, o[2]); g0 = VF(15); EXP3(Y0, 6); SBAR();
    o[3] = MFB(pa2, g1, o[3]); EXP3(Y0, 9); SBAR();
    o[2] = MFB(pa3, g2, o[2]); EXP3(Y0, 12); SBAR();
    o[3] = MFB(pa3, g0, o[3]); Y0[15] = EX2(Y0[15]);
    asm volatile("" : "+v"(Y0), "+v"(Y1));
    SBAR();
#undef VF
}
__device__ __forceinline__ void body(const signed char* __restrict__ Qb, const signed char* __restrict__ Kh, const bf16_t* __restrict__ Vh, bf16_t* __restrict__ Ob, int seq, LAS unsigned char* L) {
    char* lds = (char*)L;
    int tid_ = threadIdx.x; asm volatile("" : "+v"(tid_));
    const int tid = tid_, wid = tid >> 6, lane = tid & 63, r32 = lane & 31, hi = lane >> 5;
    const int wu = __builtin_amdgcn_readfirstlane(wid);
    float* ws = (float*)(lds + WS_OFF) + wid * 64; float* li_l = ws; float* al_l = ws + 32;
    float m_reg = -1e30f, l_reg = 0; f32x16 o[4] = {}; i32x4 qr[6];
    const signed char* Qw = Qb + (long)(wid * QBLK + r32) * DQ + hi * 16;
#pragma unroll
    for (int ks = 0; ks < 6; ++ks) qr[ks] = *reinterpret_cast<const i32x4*>(Qw + ks * 32);
    i32x16 mg;
#pragma unroll
    for (int r = 0; r < 16; ++r) mg[r] = 0x4B400000;
    asm volatile("" : "+v"(mg));
    unsigned vsa, vsb, ksa, ksb;
    { const int d = (2 * wid) * 64 + lane, S = d >> 5, kk = (S >> 2) * 8 + ((d >> 2) & 7), c8 = (S & 3) * 4 + (d & 3), k = (kk & ~0xC) | ((kk & 4) << 1) | ((kk & 8) >> 1); vsa = (unsigned)(k * 256 + c8 * 16); }
    { const int d = (2 * wid + 1) * 64 + lane, S = d >> 5, kk = (S >> 2) * 8 + ((d >> 2) & 7), c8 = (S & 3) * 4 + (d & 3), k = (kk & ~0xC) | ((kk & 4) << 1) | ((kk & 8) >> 1); vsb = (unsigned)(k * 256 + c8 * 16); }
    { const int d = wid * 64 + lane, row = d / 13, pc = d - row * 13; ksa = (unsigned)(row * DQ + (pc < 12 ? pc : 11) * 16); }
    { const int d = (8 + (wid < 5 ? wid : 4)) * 64 + lane, row = d / 13, pc = d - row * 13; ksb = (unsigned)(row * DQ + (pc < 12 ? pc : 11) * 16); }
#define STAGE(k0, slot) do { const char* _vb = (const char*)Vh + (size_t)(k0) * DV * 2; const char* _kb = (const char*)Kh + (size_t)(k0) * DQ; \
    LAS unsigned char* _vd = L + (slot) * SHM_V + wu * 2048; LAS unsigned char* _kd = L + K_OFF + (slot) * SHM_K + wu * 1024; \
    __builtin_amdgcn_global_load_lds((const unsigned*)(_vb + vsa), (LAS unsigned*)_vd, 16, 0, 0); \
    __builtin_amdgcn_global_load_lds((const unsigned*)(_vb + vsb), (LAS unsigned*)(_vd + 1024), 16, 0, 0); \
    __builtin_amdgcn_global_load_lds((const unsigned*)(_kb + ksa), (LAS unsigned*)_kd, 16, 0, 0); \
    __builtin_amdgcn_global_load_lds((const unsigned*)(_kb + ksb), (LAS unsigned*)(L + K_OFF + (slot) * SHM_K + (8 + (wu < 5 ? wu : 4)) * 1024), 16, 0, 0); } while (0)
#define SWAIT() asm volatile("s_waitcnt vmcnt(0)" ::: "memory")
#define RESC(a) do { if (__any((a) < 1.f)) { if (hi == 0) al_l[r32] = (a); asm volatile("s_waitcnt lgkmcnt(0)" ::: "memory"); \
    _Pragma("unroll") for (int d = 0; d < 4; ++d) _Pragma("unroll") for (int r = 0; r < 16; ++r) o[d][r] *= al_l[crow(r, hi)]; } } while (0)
#define ROT() do { const int _t = b0; b0 = b1; b1 = b2; b2 = _t; } while (0)
    const int kl = K_OFF + r32 * KROW + hi * 16;
    const LAS unsigned char* vl = L + v_rd_base(lane);
#define HALF(X0, X1, alX, Y0, Y1, alY) do { \
    region1(Y0, Y1, X0, X1, alX, l_reg, pa0, pa1, pa2, pa3, lds + kl + b1 * SHM_K, qr, mg); \
    region2(o, Y0, Y1, m_reg, alY, pa0, pa1, pa2, pa3, vl + b0 * SHM_V); \
    RESC(alY); } while (0)
    f32x16 pA0, pA1, pB0, pB1; float alA, alB; bf16x8 pa0, pa1, pa2, pa3; const int NT_ = seq / KVBLK;
    int b0 = 0, b1 = 1, b2 = 2;
    STAGE(0, 0); STAGE(KVBLK, 1); SWAIT(); __syncthreads();
    {
        const char* kb = lds + kl; i32x16 a0, a1;
#pragma unroll
        for (int ks = 0; ks < 6; ++ks) { const i32x4 f0 = *reinterpret_cast<const i32x4*>(kb + ks * 32), f1 = *reinterpret_cast<const i32x4*>(kb + 32 * KROW + ks * 32);
            if (ks == 0) { a0 = MF8(f0, qr[0], mg); a1 = MF8(f1, qr[0], mg); } else { a0 = MF8(f0, qr[ks], a0); a1 = MF8(f1, qr[ks], a1); } }
        pA0 = __builtin_bit_cast(f32x16, a0); pA1 = __builtin_bit_cast(f32x16, a1);
        float pm = pA0[0], pn = pA0[1], mc;
        MAX8(pA0, 0); MAX8(pA0, 8); MAX8(pA1, 0); MAX8(pA1, 8);
        pm = fmaxf(pm, pn); { auto rr = __builtin_amdgcn_permlane32_swap(__float_as_uint(pm), __float_as_uint(pm), false, false); pm = fmaxf(__uint_as_float(rr[0]), __uint_as_float(rr[1])); }
        pm = (pm - MAGIC) * SC; m_reg = pm; alA = 0.f; mc = -(pm + MAGIC * SC);
        FMA8(pA0, 0); FMA8(pA0, 8); FMA8(pA1, 0); FMA8(pA1, 8); EXP4(pA0, 0); EXP4(pA0, 4); EXP4(pA0, 8); EXP4(pA0, 12);
    }
#pragma clang loop unroll(disable)
    for (int j = 1; j + 1 < NT_; j += 2) {
        STAGE((j + 1) * KVBLK, b2);
        HALF(pA0, pA1, alA, pB0, pB1, alB);
        SWAIT(); __syncthreads(); ROT();
        STAGE((j + 2) * KVBLK, b2);
        HALF(pB0, pB1, alB, pA0, pA1, alA);
        SWAIT(); __syncthreads(); ROT();
    }
    HALF(pA0, pA1, alA, pB0, pB1, alB);
    {
        float ps = 0.f, pt = 0.f;
        EXP4(pB1, 0); EXP4(pB1, 4); EXP4(pB1, 8); EXP4(pB1, 12); ADD8(pB0, 0); ADD8(pB0, 8); ADD8(pB1, 0); ADD8(pB1, 8);
        ps += pt; { auto rr = __builtin_amdgcn_permlane32_swap(__float_as_uint(ps), __float_as_uint(ps), false, false); ps = __uint_as_float(rr[0]) + __uint_as_float(rr[1]); } l_reg = l_reg * alB + ps;
        PK4(pB0, 0, pa0); PK4(pB0, 8, pa1); PK4(pB1, 0, pa2); PK4(pB1, 8, pa3);
        const LAS unsigned char* vp = vl + b1 * SHM_V;
#pragma unroll
        for (int d0 = 0; d0 < 4; ++d0) { o[d0] = MFB(pa0, vfrag(vp, v_rd_off(d0, 0, 0)), o[d0]); o[d0] = MFB(pa1, vfrag(vp, v_rd_off(d0, 1, 0)), o[d0]);
            o[d0] = MFB(pa2, vfrag(vp, v_rd_off(d0, 2, 0)), o[d0]); o[d0] = MFB(pa3, vfrag(vp, v_rd_off(d0, 3, 0)), o[d0]); }
    }
    if (hi == 0) li_l[r32] = l_reg; asm volatile("s_waitcnt lgkmcnt(0)" ::: "memory");
    __syncthreads();
    {
        char* ot = lds + wid * 8704;
#pragma unroll
        for (int r = 0; r < 16; ++r) { const int orow = crow(r, hi); const float rl = __builtin_amdgcn_rcpf(li_l[orow]);
#pragma unroll
            for (int d0 = 0; d0 < 4; ++d0) *(bf16_t*)(ot + orow * 272 + (d0 * 32 + r32) * 2) = (bf16_t)(cvt_pk_bf16(o[d0][r] * rl, 0.f) & 0xffffu); }
        asm volatile("s_waitcnt lgkmcnt(0)" ::: "memory");
        bf16_t* Ow = Ob + (long)(wid * QBLK) * 1024;
#pragma unroll
        for (int k = 0; k < 8; ++k) { const int row = 4 * k + (lane >> 4), ch = lane & 15;
            const u32x4 v = *(const u32x4*)(ot + row * 272 + ch * 16);
            *(u32x4*)(Ow + (long)row * 1024 + ch * 8) = v; }
    }
    __syncthreads();
#undef HALF
#undef ROT
#undef STAGE
#undef SWAIT
#undef RESC
}
#undef PK4
#undef FMA8
#undef MAX8
#undef ADD8
#undef EXP3
#undef EXP4
}

typedef short v4i16_t __attribute__((ext_vector_type(4)));
__device__ __forceinline__ s16x4 tr_rd(const LAS unsigned char* p) { return __builtin_bit_cast(s16x4, __builtin_amdgcn_ds_read_tr16_b64_v4i16((LAS v4i16_t*)p)); }
__device__ __forceinline__ int swz16(int r) { return ((r & 3) << 1) | (((r >> 3) & 1) << 3) | ((r >> 2) & 1); }
__device__ __forceinline__ int swzV(int k) { return (k & 3) | (((k >> 3) & 1) << 2); }
#define MFMA16(a, b, c) __builtin_amdgcn_mfma_f32_16x16x32_bf16((a), (b), (c), 0, 0, 0)
__device__ __forceinline__ bf16x8 mk8(u32x2 lo, u32x2 hi) { u32x4 w = {lo.x, lo.y, hi.x, hi.y}; return __builtin_bit_cast(bf16x8, w); }
__device__ __forceinline__ bf16x8 mk8s(s16x4 lo, s16x4 hi) { return (bf16x8){lo[0], lo[1], lo[2], lo[3], hi[0], hi[1], hi[2], hi[3]}; }

__device__ __forceinline__ void ret_scan_unit(Frame& F, int unit, const bf16_t* __restrict__ QK, const bf16_t* __restrict__ V, bf16_t* __restrict__ YF, bf16_t* __restrict__ YB, const float* __restrict__ decay_f, const float* __restrict__ decay_b) {
    constexpr int QS = 528, KS = 544, VS = 288, PS = 144;
    const int vs = unit & 3, dir = (unit >> 2) & 1, h = (unit >> 3) & 3, b = unit >> 5;
    float lg = -expf((dir ? decay_b : decay_f)[h]) * 1.4426950408889634f;
    const int lane = F.lane, w = F.wave, l15 = lane & 15, q4 = lane >> 4, tid = F.tid;
    LAS unsigned char* Qs = F.lds; LAS unsigned char* Ks = F.lds + 64 * QS; LAS unsigned char* Vs = Ks + 2 * 64 * KS; LAS unsigned char* Ps = Vs + 64 * VS;
    const float g64 = exp2f(lg * 64.f);
    f32x4 S[16];
#pragma unroll
    for (int i = 0; i < 16; ++i) S[i] = (f32x4){0.f, 0.f, 0.f, 0.f};
    bf16_t* Y = dir ? YB : YF;
    const int ti1 = w >> 1, tj0 = 2 * (w & 1);
    const LAS unsigned char* q128 = Qs + (16 * ti1 + l15) * QS + q4 * 16;
    const LAS unsigned char* k128 = Ks + (16 * tj0 + l15) * KS + q4 * 16;
    const LAS unsigned char* q64 = Qs + l15 * QS + q4 * 8;
    const LAS unsigned char* ktr = Ks + (4 * q4 + (l15 >> 2)) * KS + (l15 & 3) * 16;
    const LAS unsigned char* vtr = Vs + (4 * q4 + (l15 >> 2)) * VS + w * 32 + (l15 & 3) * 8;
    const LAS unsigned char* pA = Ps + l15 * PS + q4 * 8;
    LAS unsigned char* pW = Ps + (16 * ti1 + l15) * PS + (16 * tj0 + 4 * q4) * 2;
#define RS_ROW0(step) ({ const int _cc = (step) < 4 ? (dir ? 3 - (step) : (step)) : (dir ? 67 - (step) : (step) - 4); (step) < 4 ? NLAT + b * 256 + 64 * _cc : b * 4096 + 64 * _cc; })
    const int wu = __builtin_amdgcn_readfirstlane(w);
    unsigned qo[5], ko[5], vo[3];
#pragma unroll
    for (int i = 0; i < 5; ++i) { int ins = i * 8 + w; ins = ins > 32 ? 32 : ins; const int d = ins * 64 + lane, row = d / 33, pc = d - 33 * row; qo[i] = (unsigned)(row * 4096 + (pc < 32 ? pc : 31) * 16); }
#pragma unroll
    for (int i = 0; i < 5; ++i) { int ins = i * 8 + w; ins = ins > 33 ? 33 : ins; const int d = ins * 64 + lane, row = d / 34, pc = d - 34 * row; ko[i] = (unsigned)(row * 4096 + (pc < 32 ? pc : 31) * 16); }
#pragma unroll
    for (int i = 0; i < 3; ++i) { int ins = i * 8 + w; ins = ins > 17 ? 17 : ins; const int d = ins * 64 + lane, row = d / 18, pc = d - 18 * row; vo[i] = (unsigned)(row * 4096 + (pc < 16 ? pc : 15) * 16); }
    const char* Qg = (const char*)(QK + 256 * h); const char* Kg = (const char*)(QK + 1024 + 256 * h); const char* Vg = (const char*)(V + 512 * h + 128 * vs);
#define RS_DMA_Q(R0) do { _Pragma("unroll") for (int _i = 0; _i < 5; ++_i) { const int _s = _i * 8 + wu; \
        __builtin_amdgcn_global_load_lds((const unsigned*)(Qg + (size_t)(R0) * 4096 + qo[_i]), (LAS unsigned*)(Qs + (_s > 32 ? 32 : _s) * 1024), 16, 0, 0); } } while (0)
#define RS_DMA_K(R0, kb) do { _Pragma("unroll") for (int _i = 0; _i < 5; ++_i) { const int _s = _i * 8 + wu; \
        __builtin_amdgcn_global_load_lds((const unsigned*)(Kg + (size_t)(R0) * 4096 + ko[_i]), (LAS unsigned*)(Ks + (kb) + (_s > 33 ? 33 : _s) * 1024), 16, 0, 0); } } while (0)
#define RS_DMA_V(R0) do { _Pragma("unroll") for (int _i = 0; _i < 3; ++_i) { const int _s = _i * 8 + wu; \
        __builtin_amdgcn_global_load_lds((const unsigned*)(Vg + (size_t)(R0) * 4096 + vo[_i]), (LAS unsigned*)(Vs + (_s > 17 ? 17 : _s) * 1024), 16, 0, 0); } } while (0)
    { const int R0 = RS_ROW0(0); RS_DMA_Q(R0); RS_DMA_K(R0, 0); RS_DMA_V(R0); }
    asm volatile("s_waitcnt vmcnt(0)" ::: "memory");
    __syncthreads();
    for (int step = 0; step < 68; ++step) {
        const int R0 = RS_ROW0(step), R1 = RS_ROW0(step + 1 < 68 ? step + 1 : step), kbo = (step & 1) * (64 * KS);
        const bool more = step + 1 < 68;
        if (more) { RS_DMA_K(R1, (64 * KS) - kbo); }
#define SB0() __builtin_amdgcn_sched_barrier(0)
        f32x4 p0 = (f32x4){0.f, 0.f, 0.f, 0.f}, p1 = p0;
        {
            const LAS unsigned char* k128b = k128 + kbo;
            bf16x8 qa[8], kb0[8], kb1[8];
#define A1RD(s_) do { qa[s_] = *(const LAS bf16x8*)(q128 + (s_) * 64); kb0[s_] = *(const LAS bf16x8*)(k128b + (s_) * 64); kb1[s_] = *(const LAS bf16x8*)(k128b + 16 * KS + (s_) * 64); } while (0)
            A1RD(0); A1RD(1); A1RD(2);
#pragma unroll
            for (int ks = 0; ks < 8; ++ks) {
                if (ks + 3 < 8) A1RD(ks + 3);
                SB0();
                p0 = MFMA16(kb0[ks], qa[ks], p0); p1 = MFMA16(kb1[ks], qa[ks], p1);
                SB0();
            }
#undef A1RD
        }
        {
            const int dbase = dir ? (16 * tj0 + 4 * q4) - (16 * ti1 + l15) : (16 * ti1 + l15) - (16 * tj0 + 4 * q4);
#pragma unroll
            for (int t = 0; t < 2; ++t) {
                const f32x4 pv = t ? p1 : p0; float val[4];
#pragma unroll
                for (int rg = 0; rg < 4; ++rg) { const int d = dir ? dbase + 16 * t + rg : dbase - 16 * t - rg;
                    val[rg] = d >= 0 ? pv[rg] * __builtin_amdgcn_exp2f(lg * (float)d) : 0.f; }
                u32x2 pw; pw.x = cvt_pk_bf16(val[0], val[1]); pw.y = cvt_pk_bf16(val[2], val[3]);
                *(LAS u32x2*)(pW + t * 32) = pw;
            }
        }
        f32x4 y[4];
#pragma unroll
        for (int ti = 0; ti < 4; ++ti) y[ti] = (f32x4){0.f, 0.f, 0.f, 0.f};
        {
            const LAS unsigned char* qrow = Qs + l15 * QS + q4 * 16;
            bf16x8 qf[8][4];
#define A2RD(s_) do { _Pragma("unroll") for (int ti = 0; ti < 4; ++ti) qf[s_][ti] = *(const LAS bf16x8*)(qrow + ti * 16 * QS + (s_) * 64); } while (0)
            A2RD(0);
#pragma unroll
            for (int ks = 0; ks < 8; ++ks) {
                if (ks < 7) A2RD(ks + 1);
                u32x4 bw; bw.x = cvt_pk_bf16(S[2 * ks][0], S[2 * ks][1]); bw.y = cvt_pk_bf16(S[2 * ks][2], S[2 * ks][3]); bw.z = cvt_pk_bf16(S[2 * ks + 1][0], S[2 * ks + 1][1]); bw.w = cvt_pk_bf16(S[2 * ks + 1][2], S[2 * ks + 1][3]);
                const bf16x8 bfr = __builtin_bit_cast(bf16x8, bw);
                SB0();
#pragma unroll
                for (int ti = 0; ti < 4; ++ti) y[ti] = MFMA16(bfr, qf[ks][ti], y[ti]);
                SB0();
            }
#undef A2RD
        }
#pragma unroll
        for (int ti = 0; ti < 4; ++ti) { const int qi = 16 * ti + l15; y[ti] = y[ti] * __builtin_amdgcn_exp2f(lg * (float)(dir ? 64 - qi : qi + 1)); }
        if (more) asm volatile("s_waitcnt vmcnt(5) lgkmcnt(0)" ::: "memory"); else asm volatile("s_waitcnt vmcnt(0) lgkmcnt(0)" ::: "memory");
        __builtin_amdgcn_s_barrier(); asm volatile("" ::: "memory");
        if (more) { RS_DMA_Q(R1); }
        bf16x8 vf[2];
#pragma unroll
        for (int ks2 = 0; ks2 < 2; ++ks2) {
            const s16x4 lo = tr_rd(vtr + ks2 * 32 * VS);
            const s16x4 hi = tr_rd(vtr + ks2 * 32 * VS + 16 * VS);
            vf[ks2] = mk8s(lo, hi);
        }
#pragma unroll
        for (int ks2 = 0; ks2 < 2; ++ks2)
#pragma unroll
            for (int ti = 0; ti < 4; ++ti) {
                const u32x2 lo = *(const LAS u32x2*)(pA + ti * 16 * PS + ks2 * 64);
                const u32x2 hi = *(const LAS u32x2*)(pA + ti * 16 * PS + ks2 * 64 + 32);
                y[ti] = MFMA16(vf[ks2], mk8(lo, hi), y[ti]);
            }
        const LAS unsigned char* ktrb = ktr + kbo;
        SB0(); asm volatile("s_nop 15\n\ts_nop 7" ::: "memory"); SB0();
        {
            bf16_t* yp = Y + (size_t)(R0 + l15) * 2048 + 512 * h + 128 * vs + 16 * w + 4 * q4;
#pragma unroll
            for (int ti = 0; ti < 4; ++ti) { u32x2 yw; yw.x = cvt_pk_bf16(y[ti][0], y[ti][1]); yw.y = cvt_pk_bf16(y[ti][2], y[ti][3]); *(u32x2*)(yp + (size_t)(16 * ti) * 2048) = yw; }
        }
        bf16x8 vp[2];
        {
            const float dk0 = __builtin_amdgcn_exp2f(lg * (float)(dir ? 4 * q4 : 63 - 4 * q4));
            float dkj[8];
#pragma unroll
            for (int j = 0; j < 8; ++j) { const int dkk = (j & 3) + 16 * (j >> 2); dkj[j] = __builtin_amdgcn_exp2f(lg * (float)(dir ? dkk : -dkk)); }
            const float dk32 = __builtin_amdgcn_exp2f(lg * (float)(dir ? 32 : -32));
#pragma unroll
            for (int ks2 = 0; ks2 < 2; ++ks2) {
                const float bs = ks2 ? dk0 * dk32 : dk0;
                const u32x4 vw = __builtin_bit_cast(u32x4, vf[ks2]); u32x4 o;
                o.x = cvt_pk_bf16(bflo(vw.x) * (bs * dkj[0]), bfhi(vw.x) * (bs * dkj[1])); o.y = cvt_pk_bf16(bflo(vw.y) * (bs * dkj[2]), bfhi(vw.y) * (bs * dkj[3]));
                o.z = cvt_pk_bf16(bflo(vw.z) * (bs * dkj[4]), bfhi(vw.z) * (bs * dkj[5])); o.w = cvt_pk_bf16(bflo(vw.w) * (bs * dkj[6]), bfhi(vw.w) * (bs * dkj[7]));
                vp[ks2] = __builtin_bit_cast(bf16x8, o);
            }
        }
        {
            s16x4 kl[16][2], kh[16][2];
#define B2RD(d_) do { _Pragma("unroll") for (int ks2 = 0; ks2 < 2; ++ks2) { kl[d_][ks2] = tr_rd(ktrb + ks2 * 32 * KS + ((d_) >> 1) * 64 + ((d_) & 1) * 8); kh[d_][ks2] = tr_rd(ktrb + ks2 * 32 * KS + 16 * KS + ((d_) >> 1) * 64 + ((d_) & 1) * 8); } } while (0)
            B2RD(0); B2RD(1);
#pragma unroll
            for (int dt = 0; dt < 16; ++dt) {
                if (dt + 2 < 16) B2RD(dt + 2);
                S[dt] = S[dt] * g64;
                SB0();
#pragma unroll
                for (int ks2 = 0; ks2 < 2; ++ks2) S[dt] = MFMA16(mk8s(kl[dt][ks2], kh[dt][ks2]), vp[ks2], S[dt]);
                SB0();
            }
#undef B2RD
        }
#undef SB0
        asm volatile("s_waitcnt vmcnt(0) lgkmcnt(0)" ::: "memory");
        __builtin_amdgcn_s_barrier(); asm volatile("" ::: "memory");
        if (more) { RS_DMA_V(R1); }
    }
#undef RS_ROW0
#undef RS_DMA_Q
#undef RS_DMA_K
#undef RS_DMA_V
}

__device__ __forceinline__ void readout_row(const bf16_t* yf, const bf16_t* yb, const unsigned char* g, signed char* o8, float* osp, int lane) {
    u32x4 a[4], bq[4]; u32x2 gf[4], gb[4];
#pragma unroll
    for (int hh = 0; hh < 4; ++hh) { a[hh] = *(const u32x4*)(yf + 512 * hh + 8 * lane); bq[hh] = *(const u32x4*)(yb + 512 * hh + 8 * lane);
        gf[hh] = *(const u32x2*)(g + 512 * hh + 8 * lane); gb[hh] = *(const u32x2*)(g + 2048 + 512 * hh + 8 * lane); }
    float sa[4], sb[4];
#pragma unroll
    for (int hh = 0; hh < 4; ++hh) { float x = 0.f, y = 0.f;
#pragma unroll
        for (int i = 0; i < 4; ++i) { const float a0 = bflo(a[hh][i]), a1 = bfhi(a[hh][i]), b0 = bflo(bq[hh][i]), b1 = bfhi(bq[hh][i]); x += a0 * a0 + a1 * a1; y += b0 * b0 + b1 * b1; }
        sa[hh] = x; sb[hh] = y; }
#pragma unroll
    for (int of = 1; of < 64; of <<= 1) {
#pragma unroll
        for (int hh = 0; hh < 4; ++hh) { sa[hh] += __shfl_xor(sa[hh], of); sb[hh] += __shfl_xor(sb[hh], of); }
    }
    float ov[4][8]; float m = 0.f;
#pragma unroll
    for (int hh = 0; hh < 4; ++hh) {
        const float ra = rsqrtf(sa[hh] * (1.f / 512.f) + EPS), rb = rsqrtf(sb[hh] * (1.f / 512.f) + EPS);
#pragma unroll
        for (int i = 0; i < 4; ++i) {
            const f32x2 gfv = (i & 1) ? __builtin_amdgcn_cvt_pk_f32_fp8((int)gf[hh][i >> 1], true) : __builtin_amdgcn_cvt_pk_f32_fp8((int)gf[hh][i >> 1], false);
            const f32x2 gbv = (i & 1) ? __builtin_amdgcn_cvt_pk_f32_fp8((int)gb[hh][i >> 1], true) : __builtin_amdgcn_cvt_pk_f32_fp8((int)gb[hh][i >> 1], false);
            ov[hh][2 * i] = siluf(gfv.x) * bflo(a[hh][i]) * ra + siluf(gbv.x) * bflo(bq[hh][i]) * rb;
            ov[hh][2 * i + 1] = siluf(gfv.y) * bfhi(a[hh][i]) * ra + siluf(gbv.y) * bfhi(bq[hh][i]) * rb;
            m = fmaxf(m, fmaxf(fabsf(ov[hh][2 * i]), fabsf(ov[hh][2 * i + 1])));
        }
    }
    m = wave_max(m);
    const float sc = m > 0.f ? m * (1.f / 127.f) : 1.f, inv = 1.f / sc;
#pragma unroll
    for (int hh = 0; hh < 4; ++hh) { u32x2 w; w.x = pack_i8x4(ov[hh][0] * inv, ov[hh][1] * inv, ov[hh][2] * inv, ov[hh][3] * inv); w.y = pack_i8x4(ov[hh][4] * inv, ov[hh][5] * inv, ov[hh][6] * inv, ov[hh][7] * inv);
        *(u32x2*)(o8 + 512 * hh + 8 * lane) = w; }
    if (lane == 0) *osp = sc;
}

__global__ void __launch_bounds__(NTHR, 2) fwd_kernel(Args args) {
    extern __shared__ __attribute__((aligned(16))) unsigned char lds_raw[];
    Frame F;
    F.lds = (LAS unsigned char*)lds_raw;
    F.tid = threadIdx.x; F.lane = F.tid & 63; F.wave = __builtin_amdgcn_readfirstlane(F.tid >> 6);
    F.G = gridDim.x; { const int bx = blockIdx.x; F.vcu = (F.G % 8 == 0) ? (bx % 8) * (F.G / 8) + bx / 8 : bx; }
    F.ws = args.ws; F.ctl = (unsigned*)(args.ws + WS_CTL);
    volatile LAS unsigned* MISC = (volatile LAS unsigned*)(F.lds + LDSCTL_OFF);
    for (int u = F.tid; u < (LDS_BYTES - LDSCTL_OFF) / 4; u += NTHR) ((LAS unsigned*)(F.lds + LDSCTL_OFF))[u] = 0u;
    __syncthreads();
    XcdBarrier bar; bar.bar = F.ctl + CW_BAR; bar.x = 0; bar.st = nullptr;
    if (MK_ONE_LAUNCH) bar = xcd_barrier_post(F.ctl + CW_BAR, MISC + 8);
    const int lo = args.ph_lo, hi = args.ph_hi;
#ifndef PHMASK
#define PHMASK 0xffffffffu
#endif
#define IN(k) (((PHMASK >> (k)) & 1u) && lo <= (k) && (k) < hi)
#define SEAM(k) do { if (MK_ONE_LAUNCH && IN((k) + 1)) xcd_barrier(bar); } while (0)

    const float* x = (const float*)args.in[0]; const float* c = (const float*)args.in[1]; const float* ctx = (const float*)args.in[2]; const float* c_ctx = (const float*)args.in[3];
    const float* ada_w = (const float*)args.in[4]; const float* ada_b = (const float*)args.in[5]; const float* norm_mix = (const float*)args.in[6]; const float* norm_ffn = (const float*)args.in[7];
    float* MOD = (float*)(F.ws + WS_MOD);
    bf16_t* H = (bf16_t*)(F.ws + WS_H);
    signed char* H8 = (signed char*)(F.ws + WS_H8); float* HS = (float*)(F.ws + WS_HS); signed char* O8 = (signed char*)(F.ws + WS_O); float* OS = (float*)(F.ws + WS_OS);
    bf16_t* XB = (bf16_t*)(F.ws + WS_XB);
    float* out = args.out;
    const int gw = F.vcu * NWAVES + F.wave, NGW = F.G * NWAVES;

    if (IN(0)) {
        mod_vectors(F, c, c_ctx, ada_w, ada_b, MOD);
        __syncthreads();
        rope_tables(F, (f32x2*)(F.ws + WS_TABR), (f32x2*)(F.ws + WS_TABM));
        {
        int cb = 0;
        conv_job(F, cb, (const float*)args.in[14], (bf16_t*)(F.ws + WS_W_QB), 384, 1536, 1536, 0, 1, 0, 0, (const float*)args.in[13]);
        conv_job(F, cb, (const float*)args.in[16], (bf16_t*)(F.ws + WS_W_KVB), 256, 2048, 2048, 0, 1, 0, 0, (const float*)args.in[15]);
        conv_job(F, cb, (const float*)args.in[19], (bf16_t*)(F.ws + WS_W_MO), 1024, 1024, 1024, 0, 1, 0, 0);
        conv_job(F, cb, (const float*)args.in[20], (bf16_t*)(F.ws + WS_W_RT), 1024, 64, 256, 3, 2, (size_t)1024 * 64, (size_t)256 * 1024);
        conv_job(F, cb, (const float*)args.in[25], (bf16_t*)(F.ws + WS_W_SD), 256, 1024, 1024, 0, 2, (size_t)256 * 1024, (size_t)1024 * 256);
        conv_job(F, cb, (const float*)args.in[23], (bf16_t*)(F.ws + WS_W_ED), 256, 1024, 1024, 0, 64, (size_t)256 * 1024, (size_t)1024 * 256);
        __syncthreads();
        int c8 = 0;
        conv8_job<2, true>(F, c8, (const float*)args.in[8], (signed char*)(F.ws + WS_W_RI8), (float*)(F.ws + WS_CS_RI), 1024, 8192, 8192, 1, 1, 0);
        conv8_job<4, false>(F, c8, (const float*)args.in[11], (signed char*)(F.ws + WS_W_RO8), (float*)(F.ws + WS_CS_RO), 2048, 1024, 1024, 0, 1, 0);
        conv8_job<2, true>(F, c8, (const float*)args.in[12], (signed char*)(F.ws + WS_W_MI8), (float*)(F.ws + WS_CS_MI), 1024, 704, 768, 3, 1, 0);
        conv8_job<2, true>(F, c8, (const float*)args.in[24], (signed char*)(F.ws + WS_W_SGU8), (float*)(F.ws + WS_CS_SGU), 1024, 512, 512, 2, 2, (size_t)1024 * 512);
        conv8_job<2, true>(F, c8, (const float*)args.in[22], (signed char*)(F.ws + WS_W_EGU8), (float*)(F.ws + WS_CS_EGU), 1024, 512, 512, 2, 64, (size_t)1024 * 512);
        }
        SEAM(0);
    }
    if (IN(1)) {
        for (int rep = 0; rep < PROBE_REPS(1); ++rep)
        for (int r = gw; r < NT; r += NGW) {
            const float* xr = r < NLAT ? x + (size_t)r * DM : ctx + (size_t)(r - NLAT) * DM;
            const float* md = MOD + (size_t)(0 * 9 + mod_row_of(r)) * 6144;
            norm_mod_row(xr, norm_mix, md, md + 1024, nullptr, H8 + (size_t)r * DM, HS + r, F.lane);
        }
        SEAM(1);
    }
    bf16_t* QKb = (bf16_t*)(F.ws + WS_QK); bf16_t* Vb = (bf16_t*)(F.ws + WS_V); bf16_t* Gb = (bf16_t*)(F.ws + WS_G);
    bf16_t* YFb = (bf16_t*)(F.ws + WS_YF); bf16_t* YBb = (bf16_t*)(F.ws + WS_YB); bf16_t* Ob = (bf16_t*)(F.ws + WS_O);
    if (IN(2)) {
        g8::DenseSched S; S.init(H8, 512, F.ws + WS_W_RI8, 512, NT, RET_IN, F.G, (int)blockIdx.x, HS, (const float*)(F.ws + WS_CS_RI));
        EpiRetProj E{QKb, Vb, Gb, (const f32x4*)(F.ws + WS_TABR)};
        g8::gemm_phase<true>(F.lds, 512, 512, 512, S, E);
        SEAM(2);
    }
    if (IN(3)) {
        for (int rep = 0; rep < PROBE_REPS(3); ++rep)
        for (int u = F.vcu; u < 256; u += F.G) ret_scan_unit(F, u, QKb, Vb, YFb, YBb, (const float*)args.in[9], (const float*)args.in[10]);
        SEAM(3);
    }
    if (IN(4)) {
        for (int rep = 0; rep < PROBE_REPS(4); ++rep)
        for (int r = gw; r < NT; r += NGW) readout_row(YFb + (size_t)r * 2048, YBb + (size_t)r * 2048, (const unsigned char*)Gb + (size_t)r * 4096, O8 + (size_t)r * 2048, OS + r, F.lane);
        SEAM(4);
    }
    if (IN(5)) {
        g8::DenseSched S; S.init(O8, 1024, F.ws + WS_W_RO8, 1024, NT, DM, F.G, (int)blockIdx.x, OS, (const float*)(F.ws + WS_CS_RO));
        EpiResid<false> E{x, ctx, XB, MOD + 2 * 1024};
        g8::gemm_phase<true>(F.lds, 1024, 1024, 1024, S, E);
        SEAM(5);
    }
    float* LOGIT = (float*)(F.ws + WS_LOGIT); int* RTP = (int*)(F.ws + WS_RT_P); int* LIST = (int*)(F.ws + WS_LIST); float* RTW = (float*)(F.ws + WS_LISTW); float* LISTS = (float*)(F.ws + WS_LISTS);
    bf16_t* ACT = (bf16_t*)(F.ws + WS_ACT); unsigned char* YS = (unsigned char*)(F.ws + WS_YS);
    const float* router_bias = (const float*)args.in[21];
    if (IN(6)) {
        for (int c0 = F.vcu; c0 < NT / 136; c0 += F.G) { norm_router_block(F, 0, c0 * 136, 136, XB, norm_ffn, MOD, (const bf16_t*)(F.ws + WS_W_RT), H8, HS, LOGIT);
            route_block(F, 0, c0 * 136, 136, LOGIT, router_bias, LIST, RTW, RTP, HS, LISTS); }
        SEAM(8);
    }
    if (IN(9)) {
        build_tpre(F, 0, NT);
        g8::GroupSched<true> S; S.tpre = (const LAS int*)(F.lds + LDS_TPRE); S.cnts = (const LAS int*)(F.lds + LDS_CNTS);
        S.A = (const char*)H8; S.B = (const char*)(F.ws + WS_W_EGU8); S.Bsh = (const char*)(F.ws + WS_W_SGU8); S.list = LIST; S.lda = 512; S.ldb = 512; S.ncu = 2; S.bexp = (size_t)512 * 1024; S.G = F.G; S.c = F.vcu; S.total = S.tpre[65] * 2;
        S.rs = HS; S.rsls = LISTS; S.cs = (const float*)(F.ws + WS_CS_EGU); S.cssh = (const float*)(F.ws + WS_CS_SGU); S.ncols = 512;
        EpiAct E{ACT};
        g8::gemm_phase<true>(F.lds, 512, 512, 512, S, E);
        SEAM(9);
    }
    if (IN(10)) {
        build_tpre(F, 0, NT);
        g8::GroupSched<false> S; S.tpre = (const LAS int*)(F.lds + LDS_TPRE); S.cnts = (const LAS int*)(F.lds + LDS_CNTS);
        S.A = (const char*)ACT; S.B = (const char*)(F.ws + WS_W_ED); S.Bsh = (const char*)(F.ws + WS_W_SD); S.list = nullptr; S.lda = 256; S.ldb = 256; S.ncu = 4; S.bexp = (size_t)1024 * 256 * 2; S.G = F.G; S.c = F.vcu; S.total = S.tpre[65] * 4; S.rs = nullptr; S.rsls = nullptr; S.cs = nullptr; S.cssh = nullptr; S.ncols = 0;
        EpiDown E{YS}; g8::gemm_phase<false>(F.lds, 256, 256, 256, S, E);
        SEAM(10);
    }
    if (IN(11)) {
        build_tpre(F, 0, NT);
        for (int r = gw; r < NT; r += NGW) {
            bf16_t* xr = XB + (size_t)r * DM;
            const float* md0 = MOD + (size_t)(0 * 9 + mod_row_of(r)) * 6144; const float* md1 = MOD + (size_t)(1 * 9 + mod_row_of(r)) * 6144;
            combine_row<false>(F, RTP, RTW, r, YS, xr, nullptr, xr, md0 + 5 * 1024, true, norm_mix + DM, md1, md1 + 1024, H8 + (size_t)r * DM, HS + r);
        }
        __syncthreads();
        int cb = 0;
        conv_job(F, cb, (const float*)args.in[23] + (size_t)64 * 256 * 1024, (bf16_t*)(F.ws + WS_W_ED), 256, 1024, 1024, 0, 64, (size_t)256 * 1024, (size_t)1024 * 256);
        __syncthreads();
        int c8 = 0;
        conv8_job<2, true>(F, c8, (const float*)args.in[22] + (size_t)64 * 1024 * 512, (signed char*)(F.ws + WS_W_EGU8), (float*)(F.ws + WS_CS_EGU), 1024, 512, 512, 2, 64, (size_t)1024 * 512);
        SEAM(11);
    }
    bf16_t* Abuf = (bf16_t*)(F.ws + WS_A); bf16_t* AQN = (bf16_t*)(F.ws + WS_AQN); bf16_t* AKVN = (bf16_t*)(F.ws + WS_AKVN); bf16_t* KROPE = (bf16_t*)(F.ws + WS_KROPE);
    bf16_t* QRAW = (bf16_t*)(F.ws + WS_QRAW); bf16_t* KVRAW = (bf16_t*)(F.ws + WS_KVRAW); signed char* QF = (signed char*)(F.ws + WS_QF); signed char* KF = (signed char*)(F.ws + WS_KF); bf16_t* VF = (bf16_t*)(F.ws + WS_VF);
    bf16_t* OATT = (bf16_t*)(F.ws + WS_OATT);
    const f32x2* TABM = (const f32x2*)(F.ws + WS_TABM);
    if (IN(12)) {
        g8::DenseSched S; S.init(H8, 512, F.ws + WS_W_MI8, 512, NT, MLA_INP, F.G, (int)blockIdx.x, HS, (const float*)(F.ws + WS_CS_MI)); EpiStore E{Abuf, MLA_INP}; g8::gemm_phase<true>(F.lds, 512, 512, 512, S, E);
        SEAM(12);
    }
    if (IN(14)) {
        for (int rep = 0; rep < 1; ++rep) {
        { g8::DenseSched S; S.init(Abuf, MLA_INP, F.ws + WS_W_QB, MLA_QR, NLAT, 1536, F.G, (int)blockIdx.x); EpiStore E{QRAW, 1536}; g8::gemm_phase<false>(F.lds, MLA_QR, MLA_INP, MLA_QR, S, E); if ((PROBE_MASK >> 14) & 1u) g8::gemm_phase<false>(F.lds, MLA_QR, MLA_QR, MLA_QR, S, E); }
        { g8::DenseSched S; S.init(Abuf + MLA_QR, MLA_INP, F.ws + WS_W_KVB, MLA_KVR, NT, 2048, F.G, (int)blockIdx.x); EpiStore E{KVRAW, 2048}; g8::gemm_phase<false>(F.lds, MLA_KVR, MLA_INP, MLA_KVR, S, E); if ((PROBE_MASK >> 14) & 1u) g8::gemm_phase<false>(F.lds, MLA_KVR, MLA_KVR, MLA_KVR, S, E); }
        }
        SEAM(14);
    }
    if (IN(15)) {
        for (int rep = 0; rep < PROBE_REPS(15); ++rep)
        for (int r = gw; r < NT; r += 2 * NGW) {
            mla_final_row(r, Abuf, QRAW, KVRAW, (const float*)args.in[17], (const float*)args.in[18], TABM, QF, KF, VF, F.lane);
            if (r + NGW < NT) mla_final_row(r + NGW, Abuf, QRAW, KVRAW, (const float*)args.in[17], (const float*)args.in[18], TABM, QF, KF, VF, F.lane); }
        SEAM(15);
    }
    if (IN(16)) {
        for (int rep = 0; rep < PROBE_REPS(16); ++rep)
        for (int u = F.vcu; u < 1024; u += F.G) { const int bh = u >> 4, qb = u & 15, b = bh >> 3, h = bh & 7;
            att::body(QF + ((size_t)bh * 4096 + qb * 256) * 192, KF + (size_t)bh * SKV * 192, VF + (size_t)bh * SKV * 128, OATT + ((size_t)b * 4096 + qb * 256) * 1024 + h * 128, SKV, F.lds); }
        SEAM(16);
    }
    if (IN(17)) {
        g8::DenseSched S; S.init(OATT, DM, F.ws + WS_W_MO, DM, NLAT, DM, F.G, (int)blockIdx.x); EpiResid<true> E{nullptr, nullptr, XB, MOD + 9 * 6144 + 2 * 1024}; g8::gemm_phase<false>(F.lds, DM, DM, DM, S, E);
        SEAM(17);
    }
    if (IN(18)) {
        for (int c0 = F.vcu; c0 < NLAT / 128; c0 += F.G) { norm_router_block(F, 1, c0 * 128, 128, XB, norm_ffn + DM, MOD + (size_t)9 * 6144, (const bf16_t*)(F.ws + WS_W_RT) + (size_t)256 * 1024, H8, HS, LOGIT);
            route_block(F, 1, c0 * 128, 128, LOGIT, router_bias + 64, LIST, RTW, RTP, HS, LISTS); }
        SEAM(20);
    }
    if (IN(21)) {
        build_tpre(F, 1, NLAT);
        g8::GroupSched<true> S; S.tpre = (const LAS int*)(F.lds + LDS_TPRE); S.cnts = (const LAS int*)(F.lds + LDS_CNTS);
        S.A = (const char*)H8; S.B = (const char*)(F.ws + WS_W_EGU8); S.Bsh = (const char*)(F.ws + WS_W_SGU8 + (size_t)512 * 1024); S.list = LIST; S.lda = 512; S.ldb = 512; S.ncu = 2; S.bexp = (size_t)512 * 1024; S.G = F.G; S.c = F.vcu; S.total = S.tpre[65] * 2;
        S.rs = HS; S.rsls = LISTS; S.cs = (const float*)(F.ws + WS_CS_EGU); S.cssh = (const float*)(F.ws + WS_CS_SGU) + 512; S.ncols = 512;
        EpiAct E{ACT};
        g8::gemm_phase<true>(F.lds, 512, 512, 512, S, E);
        SEAM(21);
    }
    if (IN(22)) {
        build_tpre(F, 1, NLAT);
        g8::GroupSched<false> S; S.tpre = (const LAS int*)(F.lds + LDS_TPRE); S.cnts = (const LAS int*)(F.lds + LDS_CNTS);
        S.A = (const char*)ACT; S.B = (const char*)(F.ws + WS_W_ED); S.Bsh = (const char*)(F.ws + WS_W_SD + (size_t)1024 * 256 * 2); S.list = nullptr; S.lda = 256; S.ldb = 256; S.ncu = 4; S.bexp = (size_t)1024 * 256 * 2; S.G = F.G; S.c = F.vcu; S.total = S.tpre[65] * 4; S.rs = nullptr; S.rsls = nullptr; S.cs = nullptr; S.cssh = nullptr; S.ncols = 0;
        EpiDown E{YS}; g8::gemm_phase<false>(F.lds, 256, 256, 256, S, E);
        SEAM(22);
    }
    if (IN(23)) {
        build_tpre(F, 1, NLAT);
        for (int r = gw; r < NLAT; r += NGW) { const float* md1 = MOD + (size_t)(1 * 9 + (r >> 12)) * 6144;
            combine_row<true>(F, RTP, RTW, r, YS, XB + (size_t)r * DM, out + (size_t)r * DM, nullptr, md1 + 5 * 1024, false, norm_mix, md1, md1, H8, HS); }
    }
#undef IN
#undef SEAM
}

constexpr int N_PHASES = 24;
extern "C" void kernel_launch(void* const* d_in, const int* in_sizes, int n_in, void* d_out, int out_size, void* d_ws, size_t ws_size, hipStream_t stream) {
    static int grid = 0;
    if (grid == 0) {
        if (n_in != 26 || out_size != NLAT * DM || ws_size < WS_END) { fprintf(stderr, "kernel_launch: unexpected shapes: n_in %d out %d ws %zu (need %zu)\n", n_in, out_size, ws_size, (size_t)WS_END); grid = -1; return; }
        int dev = 0, cus = 0, per_cu = 0;
        if (hipGetDevice(&dev) != hipSuccess || hipDeviceGetAttribute(&cus, hipDeviceAttributeMultiprocessorCount, dev) != hipSuccess) { grid = -1; return; }
        if (hipFuncSetAttribute((const void*)fwd_kernel, hipFuncAttributeMaxDynamicSharedMemorySize, LDS_BYTES) != hipSuccess) { fprintf(stderr, "kernel_launch: hipFuncSetAttribute failed\n"); grid = -1; return; }
        if (hipOccupancyMaxActiveBlocksPerMultiprocessor(&per_cu, (const void*)fwd_kernel, NTHR, LDS_BYTES) != hipSuccess || per_cu < 1) fprintf(stderr, "kernel_launch: occupancy query says %d\n", per_cu);
        (void)hipGetLastError();
        grid = cus;
    }
    if (grid < 0) return;
    (void)hipMemsetAsync((char*)d_ws + WS_CTL, 0, CTL_ZERO_BYTES, stream);
    Args a{};
    for (int i = 0; i < 26; ++i) a.in[i] = d_in[i];
    a.out = (float*)d_out; a.ws = (unsigned char*)d_ws;
    const int last = N_PHASES < MK_LAST_PHASE ? N_PHASES : MK_LAST_PHASE;
    if (MK_ONE_LAUNCH) {
        a.ph_lo = 0; a.ph_hi = last;
        hipLaunchKernelGGL(fwd_kernel, dim3(grid), dim3(NTHR), LDS_BYTES, stream, a);
    } else {
        for (int p = 0; p < last; ++p) { a.ph_lo = p; a.ph_hi = p + 1; hipLaunchKernelGGL(fwd_kernel, dim3(grid), dim3(NTHR), LDS_BYTES, stream, a); }
    }
    const hipError_t le = hipPeekAtLastError();
    if (le != hipSuccess) fprintf(stderr, "kernel_launch: launch failed: %s\n", hipGetErrorName(le));
}
```

```cpp
#include <hip/hip_runtime.h>
#include <cstdio>
#include <cstdint>

#ifndef MK_ONE_LAUNCH
#define MK_ONE_LAUNCH 1
#endif
#ifndef PROBE_MASK
#define PROBE_MASK 0u
#endif
#define PROBE_REPS(k) (((PROBE_MASK >> (k)) & 1u) ? 2 : 1)
#ifndef MK_LAST_PHASE
#define MK_LAST_PHASE 99
#endif

#define LAS __attribute__((address_space(3)))
#define GAS __attribute__((address_space(1)))
typedef unsigned short bf16_t;
typedef short bf16x8 __attribute__((ext_vector_type(8)));
typedef short s16x4 __attribute__((ext_vector_type(4)));
typedef float f32x4 __attribute__((ext_vector_type(4)));
typedef float f32x2 __attribute__((ext_vector_type(2)));
typedef float f32x16 __attribute__((ext_vector_type(16)));
typedef unsigned u32x4 __attribute__((ext_vector_type(4)));
typedef unsigned u32x2 __attribute__((ext_vector_type(2)));
typedef int i32x4 __attribute__((ext_vector_type(4)));

constexpr int DM = 1024, NB = 8, SEQ = 4096, CTXL = 256;
constexpr int NLAT = NB * SEQ;
constexpr int NCTX = NB * CTXL;
constexpr int NT = NLAT + NCTX;
constexpr int RET_H = 4, RET_DK = 256, RET_DV = 512, RET_VW = 2048, RET_IN = 8192;
constexpr int MLA_H = 8, MLA_NOPE = 128, MLA_ROPE = 64, MLA_QK = 192, MLA_V = 128, MLA_QR = 384, MLA_KVR = 256, MLA_IN = 704, MLA_INP = 768;
constexpr int SKV = SEQ + CTXL;
constexpr int NE = 64, TOPK = 8, EFF = 256;
constexpr float EPS = 1e-6f;
constexpr int NWAVES = 8, NTHR = 512;

constexpr size_t MiB = 1u << 20;
constexpr size_t WS_CTL = 0, CTL_ZERO_BYTES = 1 * MiB;
constexpr size_t WS_MOD = 1 * MiB;
constexpr size_t WS_TABR = 1 * MiB + 512 * 1024;
constexpr size_t WS_TABM = WS_TABR + 64 * 64 * 8;
constexpr size_t WS_W_RI8 = 2 * MiB, WS_CS_RI = 10 * MiB;
constexpr size_t WS_W_RO8 = 11 * MiB, WS_CS_RO = 13 * MiB;
constexpr size_t WS_W_MI8 = 14 * MiB, WS_CS_MI = 15 * MiB;
constexpr size_t WS_W_QB = 16 * MiB;
constexpr size_t WS_W_KVB = 18 * MiB;
constexpr size_t WS_W_MO = 19 * MiB;
constexpr size_t WS_W_RT = 21 * MiB;
constexpr size_t WS_W_SGU8 = 22 * MiB, WS_CS_SGU = 23 * MiB;
constexpr size_t WS_W_SD = 24 * MiB;
constexpr size_t WS_W_EGU8 = 26 * MiB, WS_CS_EGU = 58 * MiB;
constexpr size_t WS_W_ED = 59 * MiB;
constexpr size_t WS_H8 = 92 * MiB, WS_HS = 126 * MiB;
constexpr size_t WS_OS = 127 * MiB;
constexpr size_t WS_H = 130 * MiB;
constexpr size_t WS_R = 198 * MiB;
constexpr size_t WS_XC = 1014 * MiB;
constexpr size_t WS_END = 1022 * MiB;
constexpr size_t WS_QK = WS_R, WS_V = WS_R + 136 * MiB, WS_G = WS_R + 272 * MiB, WS_YF = WS_R + 544 * MiB, WS_YB = WS_R + 680 * MiB;
constexpr size_t WS_O = WS_QK;
constexpr int MOE_ROWS = 294912 + NT;
constexpr size_t WS_RT_P = WS_R;
constexpr size_t WS_LISTW = WS_R + 2 * MiB;
constexpr size_t WS_ACT = WS_R + 11 * MiB;
constexpr size_t WS_YS = WS_R + 172 * MiB;
constexpr size_t WS_LOGIT = WS_YS;
constexpr size_t WS_LIST = WS_YS + 16 * MiB;
constexpr size_t WS_LISTS = WS_YS + 330 * MiB;
static_assert((size_t)MOE_ROWS * 1024 <= 330 * MiB && WS_LISTS + (size_t)64 * NT * 4 <= WS_XC, "ws map");
static_assert(WS_ACT + (size_t)MOE_ROWS * 512 <= WS_YS && WS_YS + (size_t)MOE_ROWS * 2048 <= WS_XC, "ws map");
constexpr size_t WS_A = WS_R;
constexpr size_t WS_AQN = WS_R + 52 * MiB;
constexpr size_t WS_AKVN = WS_R + 76 * MiB;
constexpr size_t WS_KROPE = WS_R + 93 * MiB;
constexpr size_t WS_QRAW = WS_R + 98 * MiB;
constexpr size_t WS_KVRAW = WS_R + 194 * MiB;
constexpr size_t WS_QF = WS_R + 330 * MiB;
constexpr size_t WS_KF = WS_R + 426 * MiB;
constexpr size_t WS_VF = WS_R + 528 * MiB;
constexpr size_t WS_OATT = WS_R + 596 * MiB;
constexpr size_t WS_XB = WS_R + 700 * MiB;
static_assert(WS_OATT + (size_t)NLAT * 1024 * 2 <= WS_XB && WS_LISTS + (size_t)64 * NT * 4 <= WS_XB && WS_XB + (size_t)NT * 1024 * 2 <= WS_XC, "ws map");
constexpr int CW_BAR = 4096;
constexpr int CW_CNT = 8192;
constexpr int RING_BYTES = 131072, LDSCTL_OFF = RING_BYTES, LDS_XTRA = 147456, LDS_BYTES = 163840;

__device__ __forceinline__ unsigned cvt_pk_bf16(float lo, float hi) { unsigned r; asm volatile("v_cvt_pk_bf16_f32 %0, %1, %2" : "=v"(r) : "v"(lo), "v"(hi)); return r; }
__device__ __forceinline__ float bf2f(bf16_t b) { return __uint_as_float(((unsigned)b) << 16); }
__device__ __forceinline__ float bflo(unsigned w) { return __uint_as_float(w << 16); }
__device__ __forceinline__ float bfhi(unsigned w) { return __uint_as_float(w & 0xffff0000u); }
__device__ __forceinline__ float wave_sum(float v) {
#pragma unroll
    for (int o = 1; o < 64; o <<= 1) v += __shfl_xor(v, o);
    return v;
}
__device__ __forceinline__ float siluf(float x) { return x * __builtin_amdgcn_rcpf(1.f + __builtin_amdgcn_exp2f(-1.4426950408889634f * x)); }
#define LDS_WAIT() asm volatile("s_waitcnt lgkmcnt(0)" ::: "memory")
#define VM_WAIT() asm volatile("s_waitcnt vmcnt(0)" ::: "memory")

#define XB_TMO      128
#define XB_XCNT(j)  (256  + 64 * (j))
#define XB_XSUB(j)  (1280 + 64 * (j))
#define XB_XGEN(j)  (2304 + 64 * (j))
#define XB_TOP      3328
#define XB_TOPGEN   3392
#define XCD_BAR_WORDS 3456
#define XB_SPIN_CAP (1u << 22)
__device__ __forceinline__ unsigned xb_ld(unsigned* p)              { return __hip_atomic_load(p, __ATOMIC_RELAXED, __HIP_MEMORY_SCOPE_AGENT); }
__device__ __forceinline__ unsigned xb_add(unsigned* p, unsigned v) { return __hip_atomic_fetch_add(p, v, __ATOMIC_RELAXED, __HIP_MEMORY_SCOPE_AGENT); }
__device__ __forceinline__ unsigned xb_xcc_id() { return (unsigned)__builtin_amdgcn_s_getreg((3 << 11) | 20) & 0xFu; }
#define XB_SPIN(cond, bar) do { unsigned _sp = 0; while (cond) { __builtin_amdgcn_s_sleep(1); \
    if ((++_sp & 255u) == 0u) { if (xb_ld(&(bar)[XB_TMO])) break; if (_sp > XB_SPIN_CAP) { atomicAdd(&(bar)[XB_TMO], 1u); break; } } } } while (0)
struct XcdBarrier { unsigned* bar; unsigned x; volatile LAS unsigned* st; };
__device__ __forceinline__ XcdBarrier xcd_barrier_post(unsigned* bar, volatile LAS unsigned* st) {
    XcdBarrier b; b.bar = bar; b.x = xb_xcc_id(); b.st = st;
    if (threadIdx.x == 0) (void)xb_add(&bar[XB_XCNT(b.x)], 1u);
    return b;
}
__device__ __forceinline__ void xcd_barrier_complete(unsigned* bar, unsigned x, unsigned& nloc, unsigned& nx) {
    const unsigned G = gridDim.x * gridDim.y * gridDim.z;
    unsigned sum, cnt, mine, sp = 0u;
    for (;;) {
        sum = 0u; cnt = 0u; mine = 0u;
#pragma unroll
        for (unsigned j = 0; j < 16; ++j) { const unsigned c = xb_ld(&bar[XB_XCNT(j)]); sum += c; cnt += (c > 0u) ? 1u : 0u; mine = (j == x) ? c : mine; }
        if (sum == G) break;
        __builtin_amdgcn_s_sleep(1);
        if ((++sp & 255u) == 0u) { if (xb_ld(&bar[XB_TMO])) break; if (sp > XB_SPIN_CAP) { atomicAdd(&bar[XB_TMO], 1u); break; } }
    }
    nloc = mine > 0u ? mine : 1u; nx = cnt > 0u ? cnt : 1u;
}
__device__ __forceinline__ void xcd_barrier(const XcdBarrier& b) {
    asm volatile("s_waitcnt vmcnt(0)" ::: "memory");
    __syncthreads();
    if (threadIdx.x == 0) {
        unsigned* bar = b.bar;
        __builtin_amdgcn_s_waitcnt(0);
        unsigned nloc = b.st[0], nx = b.st[1];
        if (nloc == 0u) { xcd_barrier_complete(bar, b.x, nloc, nx); b.st[0] = nloc; b.st[1] = nx; }
        const unsigned old = xb_add(&bar[XB_XSUB(b.x)], 1u);
        const unsigned gen = old / nloc;
        if (old + 1u == (gen + 1u) * nloc) {
            __builtin_amdgcn_fence(__ATOMIC_RELEASE, "agent");
            asm volatile("s_waitcnt vmcnt(0)" ::: "memory");
            const unsigned og = xb_add(&bar[XB_TOP], 1u);
            const unsigned tg = og / nx;
            if (og + 1u == (tg + 1u) * nx) xb_add(&bar[XB_TOPGEN], 1u);
            else XB_SPIN(xb_ld(&bar[XB_TOPGEN]) == tg, bar);
            __builtin_amdgcn_fence(__ATOMIC_ACQUIRE, "agent");
            xb_add(&bar[XB_XGEN(b.x)], 1u);
            asm volatile("s_waitcnt vmcnt(0)" ::: "memory");
        } else {
            XB_SPIN(xb_ld(&bar[XB_XGEN(b.x)]) == gen, bar);
            __builtin_amdgcn_fence(__ATOMIC_ACQUIRE, "agent");
            asm volatile("s_waitcnt vmcnt(0)" ::: "memory");
        }
    }
    __syncthreads();
}

namespace g8 {
constexpr int BM = 256, BK = 64, HALF = 128, HTB = HALF * BK * 2, STAGE_BYTES = 8 * HTB;
__host__ __device__ __forceinline__ int lds_byte(int r, int c) { const int st = (r >> 4) * 2 + (c >> 5), rr = r & 15, cc = c & 31, ob = rr * 64 + cc * 2; return st * 1024 + (ob ^ (((ob >> 9) & 1) << 5)); }
__host__ __device__ __forceinline__ void stage_rc(int b, int& R, int& C) { const int st = b / 1024, sb = b % 1024, swz = sb ^ (((sb >> 9) & 1) << 5); R = (st >> 1) * 16 + swz / 64; C = (st & 1) * 32 + (swz % 64) / 2; }
__host__ __device__ __forceinline__ int perm32(int rho) { const int n = rho >> 4, i = rho & 15; return 8 * (i >> 2) + 4 * n + (i & 3); }

struct Unit {
    const char* A;
    const char* B;
    const int* list;
    int row0, col0;
    int nvalid;
    int rbase;
    int aux;
    const float* rsl;
    const float* cs;
};

template <class E> struct epi_nst { static constexpr int value = 0; };
template <int N> __device__ __forceinline__ void g8_wait_v() { asm volatile("s_waitcnt vmcnt(%0)" :: "n"(N) : "memory"); }
template <bool I8, class Epi, class Sched>
__device__ __forceinline__ void gemm_phase(LAS unsigned char* lds, const int K_in, const int lda, const int ldb, const Sched& S, const Epi& E) {
    int K = K_in; asm volatile("" : "+s"(K));
    const int tid = threadIdx.x, wid = __builtin_amdgcn_readfirstlane(tid >> 6), lane = tid & 63, wr = wid >> 2, wc = wid & 3, fr = lane & 15, fq = lane >> 4;
    const int nt = K / BK;
    int Rst[2], Cst[2]; unsigned voffB[2];
#pragma unroll
    for (int i = 0; i < 2; ++i) { int R, C; stage_rc(tid * 16 + i * 8192, R, C); Rst[i] = R; Cst[i] = C; const int Rb = Epi::PERM == 2 ? (64 * (R >> 5) + 16 * ((R >> 2) & 3) + 4 * ((R >> 4) & 1) + (R & 3)) : Epi::PERM == 1 ? ((R & ~31) + perm32(R & 31)) : R; voffB[i] = (unsigned)(Rb * ldb + C) * 2u; }
    const size_t kstep = (size_t)(BK * 2);
    const size_t hstepB = (size_t)(Epi::PERM == 2 ? 8 : HALF) * ldb * 2;
    const unsigned ldsw = (unsigned)wid * 1024u;
    const int aoff = lds_byte(wr * 64 + fr, fq * 8), boff = lds_byte(wc * 32 + fr, fq * 8);
#define G8_SA(b, h) (((b) * 2 + (h)) * HTB)
#define G8_SB(b, h) ((4 + (b) * 2 + (h)) * HTB)
#define G8_STAGE(bufoff, gbase, voff) do { _Pragma("unroll") for (int _i = 0; _i < 2; ++_i) { unsigned _o = (voff)[_i]; asm volatile("" : "+v"(_o));     \
        __builtin_amdgcn_global_load_lds((const unsigned*)((const char*)(gbase) + _o), (LAS unsigned*)(lds + (bufoff) + ldsw + _i * 8192), 16, 0, 0); } } while (0)
#define G8_LDA(dst, b, h) do { _Pragma("unroll") for (int m = 0; m < 4; ++m) _Pragma("unroll") for (int k = 0; k < 2; ++k) dst[m][k] = *(const LAS bf16x8*)(lds + G8_SA(b, h) + aoff + m * 2048 + k * 1024); } while (0)
#define G8_LDB(dst, b, h) do { _Pragma("unroll") for (int n = 0; n < 2; ++n) _Pragma("unroll") for (int k = 0; k < 2; ++k) dst[n][k] = *(const LAS bf16x8*)(lds + G8_SB(b, h) + boff + n * 2048 + k * 1024); } while (0)
#define G8_MMA(ai, bj, At, Bt) do { __builtin_amdgcn_s_setprio(1); _Pragma("unroll") for (int m = 0; m < 4; ++m) _Pragma("unroll") for (int n = 0; n < 2; ++n) _Pragma("unroll") for (int k = 0; k < 2; ++k) { \
        if constexpr (I8) acc[ai][bj][m][n] = __builtin_bit_cast(f32x4, __builtin_amdgcn_mfma_i32_16x16x64_i8(__builtin_bit_cast(i32x4, Bt[n][k]), __builtin_bit_cast(i32x4, At[m][k]), __builtin_bit_cast(i32x4, acc[ai][bj][m][n]), 0, 0, 0)); \
        else acc[ai][bj][m][n] = __builtin_amdgcn_mfma_f32_16x16x32_bf16(Bt[n][k], At[m][k], acc[ai][bj][m][n], 0, 0, 0); } __builtin_amdgcn_s_setprio(0); } while (0)
#define G8_MMAZ(ai, bj, At, Bt) do { __builtin_amdgcn_s_setprio(1); _Pragma("unroll") for (int m = 0; m < 4; ++m) _Pragma("unroll") for (int n = 0; n < 2; ++n) { \
        if constexpr (I8) { acc[ai][bj][m][n] = __builtin_bit_cast(f32x4, __builtin_amdgcn_mfma_i32_16x16x64_i8(__builtin_bit_cast(i32x4, Bt[n][0]), __builtin_bit_cast(i32x4, At[m][0]), (i32x4){0, 0, 0, 0}, 0, 0, 0)); \
            acc[ai][bj][m][n] = __builtin_bit_cast(f32x4, __builtin_amdgcn_mfma_i32_16x16x64_i8(__builtin_bit_cast(i32x4, Bt[n][1]), __builtin_bit_cast(i32x4, At[m][1]), __builtin_bit_cast(i32x4, acc[ai][bj][m][n]), 0, 0, 0)); } \
        else { acc[ai][bj][m][n] = __builtin_amdgcn_mfma_f32_16x16x32_bf16(Bt[n][0], At[m][0], (f32x4){0.f, 0.f, 0.f, 0.f}, 0, 0, 0); \
            acc[ai][bj][m][n] = __builtin_amdgcn_mfma_f32_16x16x32_bf16(Bt[n][1], At[m][1], acc[ai][bj][m][n], 0, 0, 0); } } __builtin_amdgcn_s_setprio(0); } while (0)
#define G8_WAIT_V(n) asm volatile("s_waitcnt vmcnt(" #n ")" ::: "memory")
#define G8_WAIT_L(n) asm volatile("s_waitcnt lgkmcnt(" #n ")" ::: "memory")
#define G8_BAR __builtin_amdgcn_s_barrier()
#define G8_SCHED __builtin_amdgcn_sched_barrier(0)
#define G8_AOFF(u, dst) do { _Pragma("unroll") for (int _h = 0; _h < 2; ++_h) _Pragma("unroll") for (int _i = 0; _i < 2; ++_i) { \
        int _r = Rst[_i] + HALF * _h; if (Sched::GATHER) { _r = (u).list ? ((_r < (u).nvalid) ? (u).list[_r] : 0) : (u).rbase + _r; } \
        dst[_h][_i] = (unsigned)(_r * lda + Cst[_i]) * 2u; } } while (0)
    constexpr bool AUX = I8;
    LAS unsigned char* const side = lds + (LDSCTL_OFF + 4096);
#define G8_AUX(u, par) do { LAS unsigned char* _sb = side + (par) * 3072; \
        if (wid < 4) { if (Sched::GATHER && (u).list) __builtin_amdgcn_global_load_lds((const unsigned*)((u).list + 64 * wid + lane), (LAS unsigned*)(_sb + wid * 256), 4, 0, 0); \
            __builtin_amdgcn_global_load_lds((const unsigned*)((u).cs + 64 * wid + lane), (LAS unsigned*)(_sb + 2048 + wid * 256), 4, 0, 0); } \
        else __builtin_amdgcn_global_load_lds((const unsigned*)((u).rsl + 64 * (wid - 4) + lane), (LAS unsigned*)(_sb + 1024 + (wid - 4) * 256), 4, 0, 0); } while (0)
#define G8_AOFF_L(u, par, dst) do { const LAS int* _sl = (const LAS int*)(side + (par) * 3072); _Pragma("unroll") for (int _h = 0; _h < 2; ++_h) _Pragma("unroll") for (int _i = 0; _i < 2; ++_i) { \
        int _r = Rst[_i] + HALF * _h; if (Sched::GATHER) { _r = (u).list ? ((_r < (u).nvalid) ? _sl[_r] : 0) : (u).rbase + _r; } \
        dst[_h][_i] = (unsigned)(_r * lda + Cst[_i]) * 2u; } } while (0)
    Unit cur, nxt; int ui = 0;
    if (!S.next(0, cur)) return;
    constexpr bool ZC = !(I8 && Sched::GATHER);
    f32x4 acc[2][2][4][2];
#pragma unroll
    for (int a = 0; a < 2; ++a)
#pragma unroll
        for (int b = 0; b < 2; ++b)
#pragma unroll
            for (int m = 0; m < 4; ++m)
#pragma unroll
                for (int n = 0; n < 2; ++n) acc[a][b][m][n] = (f32x4){0.f, 0.f, 0.f, 0.f};
    bf16x8 At[4][2], B0[2][2], B1[2][2];
    unsigned ao[2][2], an[2][2];
    if constexpr (AUX) { G8_AUX(cur, 0); G8_WAIT_V(0); G8_BAR; G8_AOFF_L(cur, 0, ao); } else { G8_AOFF(cur, ao); }
    const char* cA = cur.A; const char* cB = cur.B;
    G8_STAGE(G8_SB(0, 0), cB, voffB); G8_STAGE(G8_SB(0, 1), cB + hstepB, voffB); G8_STAGE(G8_SA(0, 0), cA, ao[0]); G8_STAGE(G8_SA(0, 1), cA, ao[1]);
    if (wr == 1) G8_BAR;
    G8_WAIT_V(2); G8_BAR;
    G8_STAGE(G8_SB(1, 0), cB + kstep, voffB); G8_STAGE(G8_SA(1, 0), cA + kstep, ao[0]); G8_STAGE(G8_SB(1, 1), cB + hstepB + kstep, voffB);
    G8_WAIT_V(6); G8_BAR;
    for (;;) {
        const bool has_next = S.next(ui + 1, nxt);
        const char* nA = has_next ? nxt.A : cA; const char* nB = has_next ? nxt.B : cB;
        if constexpr (Sched::GATHER && !AUX) { if (has_next) { G8_AOFF(nxt, an); } }
        if (!Sched::GATHER || !has_next) {
#pragma unroll
            for (int h = 0; h < 2; ++h)
#pragma unroll
                for (int i = 0; i < 2; ++i) an[h][i] = ao[h][i]; }
        for (int t = 0; t < nt; t += 2) {
            const bool last = (t == nt - 2);
            if constexpr (AUX && Sched::GATHER) { if (last && has_next) { G8_AOFF_L(nxt, (ui + 1) & 1, an); } }
            const char* a1 = cA + (size_t)(t + 1) * kstep;
            const char* a2 = last ? nA : cA + (size_t)(t + 2) * kstep; const char* b2 = last ? nB : cB + (size_t)(t + 2) * kstep;
            const char* a3 = a2 + kstep; const char* b3 = b2 + kstep;
            unsigned a2o[2][2];
#pragma unroll
            for (int h = 0; h < 2; ++h)
#pragma unroll
                for (int i = 0; i < 2; ++i) a2o[h][i] = (Sched::GATHER && last) ? an[h][i] : ao[h][i];
            constexpr int NST = epi_nst<Epi>::value; const bool relax = NST > 0 && t == 0 && ui > 0;
            G8_LDB(B0, 0, 0); G8_LDB(B1, 0, 1); G8_SCHED; G8_LDA(At, 0, 0); G8_STAGE(G8_SA(1, 1), a1, ao[1]);
            if (relax) g8_wait_v<NST + 2>(); else G8_WAIT_V(8); G8_WAIT_L(0); G8_BAR; if (ZC && t == 0) { G8_MMAZ(0, 0, At, B0); G8_MMAZ(0, 1, At, B1); } else { G8_MMA(0, 0, At, B0); G8_MMA(0, 1, At, B1); } G8_BAR; G8_SCHED;
            if constexpr (AUX) { if (t == 0 && has_next) { G8_AUX(nxt, (ui + 1) & 1); } }
            G8_LDA(At, 0, 1); G8_STAGE(G8_SB(0, 0), b2, voffB); G8_STAGE(G8_SB(0, 1), b2 + hstepB, voffB); G8_STAGE(G8_SA(0, 0), a2, a2o[0]);
            if (relax) g8_wait_v<NST + 8>(); else G8_WAIT_V(8); G8_WAIT_L(0); G8_BAR; if (ZC && t == 0) { G8_MMAZ(1, 0, At, B0); G8_MMAZ(1, 1, At, B1); } else { G8_MMA(1, 0, At, B0); G8_MMA(1, 1, At, B1); } G8_BAR; G8_SCHED;
            G8_LDB(B0, 1, 0); G8_LDB(B1, 1, 1); G8_SCHED; G8_LDA(At, 1, 0); G8_STAGE(G8_SA(0, 1), a2, a2o[1]);
            if (relax) g8_wait_v<NST + 10>(); else G8_WAIT_V(8); G8_WAIT_L(0); G8_BAR; G8_MMA(0, 0, At, B0); G8_MMA(0, 1, At, B1); G8_BAR; G8_SCHED;
            G8_LDA(At, 1, 1); G8_STAGE(G8_SB(1, 0), b3, voffB); G8_STAGE(G8_SB(1, 1), b3 + hstepB, voffB); G8_STAGE(G8_SA(1, 0), a3, a2o[0]);
            G8_WAIT_V(8); G8_WAIT_L(0); G8_BAR; G8_MMA(1, 0, At, B0); G8_MMA(1, 1, At, B1); G8_BAR; G8_SCHED;
        }
        if (wr == 0) G8_BAR;
        if constexpr (I8) {
            const LAS unsigned char* sb = side + (ui & 1) * 3072;
            f32x4 csv[2][2];
#pragma unroll
            for (int bj = 0; bj < 2; ++bj)
#pragma unroll
                for (int n = 0; n < 2; ++n) { const int cidx = (Epi::PERM == 2 ? 64 * wc + 16 * fq + 8 * bj + 4 * n : bj * 128 + wc * 32 + (Epi::PERM == 1 ? 8 * fq + 4 * n : 16 * n + 4 * fq));
                    if constexpr (AUX) csv[bj][n] = *(const LAS f32x4*)(sb + 2048 + 4 * cidx); else csv[bj][n] = *(const f32x4*)(cur.cs + cidx); }
#pragma unroll
            for (int ai = 0; ai < 2; ++ai)
#pragma unroll
                for (int m = 0; m < 4; ++m) {
                    const int r = ai * 128 + wr * 64 + m * 16 + fr;
                    float rsv; if constexpr (AUX) rsv = *(const LAS float*)(sb + 1024 + 4 * r); else rsv = cur.rsl[r];
#pragma unroll
                    for (int bj = 0; bj < 2; ++bj)
#pragma unroll
                        for (int n = 0; n < 2; ++n) { const i32x4 iv = __builtin_bit_cast(i32x4, acc[ai][bj][m][n]);
                            acc[ai][bj][m][n] = (f32x4){(float)iv.x, (float)iv.y, (float)iv.z, (float)iv.w} * csv[bj][n] * rsv; }
                }
        }
        E(acc, cur, wr, wc, fr, fq);
        if (!has_next) break;
        if constexpr (!ZC) {
#pragma unroll
            for (int a = 0; a < 2; ++a)
#pragma unroll
                for (int b = 0; b < 2; ++b)
#pragma unroll
                    for (int m = 0; m < 4; ++m)
#pragma unroll
                        for (int n = 0; n < 2; ++n) acc[a][b][m][n] = (f32x4){0.f, 0.f, 0.f, 0.f};
        }
        cur = nxt; cA = nA; cB = nB; ++ui;
        if (wr == 1) G8_BAR;
#pragma unroll
        for (int h = 0; h < 2; ++h)
#pragma unroll
            for (int i = 0; i < 2; ++i) ao[h][i] = an[h][i];
    }
    G8_WAIT_V(0);
    G8_BAR;
#undef G8_SA
#undef G8_SB
#undef G8_STAGE
#undef G8_LDA
#undef G8_LDB
#undef G8_MMA
#undef G8_MMAZ
#undef G8_WAIT_V
#undef G8_WAIT_L
#undef G8_BAR
#undef G8_SCHED
#undef G8_AOFF
#undef G8_AOFF_L
#undef G8_AUX
}

struct DenseSched {
    static constexpr bool GATHER = false;
    const char* A; const char* B; int lda, ldb;
    const float* rs; const float* cs;
    int nM, nN, nwg, G, c;
    __device__ void init(const void* A_, int lda_, const void* B_, int ldb_, int M, int N, int G_, int c_, const float* rs_ = nullptr, const float* cs_ = nullptr) { A = (const char*)A_; B = (const char*)B_; lda = lda_; ldb = ldb_; nM = M / BM; nN = N / BM; nwg = nM * nN; G = G_; c = c_; rs = rs_; cs = cs_; }
    __device__ __forceinline__ bool next(int i, Unit& u) const {
        const int L = i * G + c; if (L >= nwg) return false;
        int wgid = L; { const int q = nwg / 8, r = nwg % 8, xcd = wgid % 8, off = wgid / 8; wgid = (xcd < r ? xcd * (q + 1) : r * (q + 1) + (xcd - r) * q) + off; }
        const int nig = 8 * nN, gid = wgid / nig, fm = gid * 8, gsz = (nM - fm) < 8 ? (nM - fm) : 8;
        const int pm = fm + ((wgid % nig) % gsz), pn = (wgid % nig) / gsz;
        u.A = A + (size_t)pm * BM * lda * 2; u.B = B + (size_t)pn * BM * ldb * 2; u.list = nullptr; u.row0 = pm * BM; u.col0 = pn * BM; u.nvalid = BM; u.rbase = pm * BM; u.aux = 0; u.rsl = rs + pm * BM; u.cs = cs + pn * BM; return true;
    }
};

template <bool GATH> struct GroupSched {
    static constexpr bool GATHER = GATH;
    const LAS int* tpre; const LAS int* cnts;
    const char* A; const char* B; const char* Bsh; const int* list; int lda, ldb, ncu; size_t bexp;
    const float* rs; const float* rsls; const float* cs; const float* cssh; int ncols;
    int G, c, total;
    __device__ __forceinline__ bool next(int i, Unit& u) const {
        const int L = i * G + c; if (L >= total) return false;
        const int tg = L / ncu, cu = L % ncu, lane = threadIdx.x & 63;
        const int t0 = tpre[lane], t1 = tpre[lane + 1];
        const unsigned long long m = __ballot(t0 <= tg && tg < t1);
        const int e = m ? __builtin_amdgcn_readfirstlane((int)__builtin_ctzll(m)) : 64;
        const int tile = tg - tpre[e], cn = cnts[e];
        u.nvalid = (cn - tile * 256) < 256 ? (cn - tile * 256) : 256;
        u.list = (e < 64 && list) ? list + (size_t)e * NT + tile * 256 : nullptr; u.rbase = tile * 256;
        u.A = GATH ? A : A + (size_t)tg * 256 * lda * 2;
        u.B = (e < 64 ? B + (size_t)e * bexp : Bsh) + (size_t)cu * 256 * ldb * 2;
        u.row0 = tg * 256; u.col0 = cu * 256; u.aux = e; u.rsl = e < 64 ? rsls + (size_t)e * NT + tile * 256 : rs + tile * 256; u.cs = (e < 64 ? cs + (size_t)e * ncols : cssh) + cu * 256; return true;
    }
};
}

struct Args { const void* in[26]; float* out; unsigned char* ws; int ph_lo, ph_hi; };
struct Frame {
    LAS unsigned char* lds;
    unsigned* ctl;
    unsigned char* ws;
    int tid, lane, wave, vcu, G;
};

__device__ __forceinline__ void conv_tile(const float* W, int K, int N, bf16_t* Bt, int n0, int k0, int kind, LAS unsigned char* T, int lane, const float* kscale) {
    const int g16 = lane & 15, kp = lane >> 4;
    int srcc, orow0, ostep = 1;
    if (kind == 1 && n0 < 2048) { const int hb = n0 & ~255, p0 = n0 & 255, a = p0 >> 7, i0 = (p0 & 127) >> 1, t = g16 >> 3; srcc = hb + 128 * a + 64 * t + i0 + (g16 & 7) * 4; orow0 = 8 * (g16 & 7) + t; ostep = 2; }
    else if (kind == 2) { const int u = n0 >> 8, cc = n0 & 255; srcc = (cc < 128 ? 128 * u + cc : 256 + 128 * u + (cc - 128)) + g16 * 4; orow0 = g16 * 4; }
    else { srcc = n0 + g16 * 4; orow0 = g16 * 4; }
    const bool valid = srcc < N;
    f32x4 v0[8], v1[8];
#pragma unroll
    for (int i = 0; i < 8; ++i) { const int k = k0 + 8 * i + 2 * kp;
        v0[i] = valid ? *(const f32x4*)(W + (size_t)k * N + srcc) : (f32x4){0.f, 0.f, 0.f, 0.f};
        v1[i] = valid ? *(const f32x4*)(W + (size_t)(k + 1) * N + srcc) : (f32x4){0.f, 0.f, 0.f, 0.f};
        if (kscale) { v0[i] = v0[i] * kscale[k]; v1[i] = v1[i] * kscale[k + 1]; } }
#pragma unroll
    for (int i = 0; i < 8; ++i) { const int kk = 8 * i + 2 * kp;
#pragma unroll
        for (int j = 0; j < 4; ++j) *(LAS unsigned*)(T + (orow0 + ostep * j) * 144 + kk * 2) = cvt_pk_bf16(v0[i][j], v1[i][j]); }
    LDS_WAIT(); asm volatile("" ::: "memory");
#pragma unroll
    for (int j = 0; j < 8; ++j) { const int n = 8 * j + (lane >> 3), c = lane & 7;
        const u32x4 o = *(const LAS u32x4*)(T + n * 144 + c * 16);
        *(u32x4*)(Bt + (size_t)(n0 + n) * K + k0 + 8 * c) = o; }
    LDS_WAIT(); asm volatile("" ::: "memory");
}
__device__ __forceinline__ void conv_job(Frame& F, int& base, const float* W, bf16_t* Bt, int K, int N, int nOut, int kind, int count, size_t wstride, size_t bstride, const float* kscale = nullptr) {
    LAS unsigned char* T = F.lds + F.wave * 16384;
    const int gw = F.vcu * NWAVES + F.wave, NGW = F.G * NWAVES;
    const int nnb = nOut / 64, per = nnb * (K / 64), tot = per * count;
    int it = gw - (base % NGW); if (it < 0) it += NGW;
    for (; it < tot; it += NGW) {
        const int mi = it / per, r = it % per, nb = r % nnb, kb = r / nnb;
        conv_tile(W + (size_t)mi * wstride, K, N, Bt + (size_t)mi * bstride, nb * 64, kb * 64, kind, T, F.lane, kscale);
    }
    base += tot;
}

template <int TPW, bool HOLD>
__device__ __forceinline__ void conv8_item(Frame& F, const float* W, int K, int N, signed char* B8, float* cs, int n0, int kind) {
    const int lane = F.lane, g16 = lane & 15, kp = lane >> 4;
    LAS float* cmax = (LAS float*)F.lds; LAS unsigned char* T = F.lds + 4096 + F.wave * 5120;
    int srcc, orow0, ostep = 1;
    if (kind == 1 && n0 < 2048) { const int hb = n0 & ~255, p0 = n0 & 255, a = p0 >> 7, i0 = (p0 & 127) >> 1, t = g16 >> 3; srcc = hb + 128 * a + 64 * t + i0 + (g16 & 7) * 4; orow0 = 8 * (g16 & 7) + t; ostep = 2; }
    else if (kind == 2) { const int u = n0 >> 8, cc = n0 & 255; srcc = (cc < 128 ? 128 * u + cc : 256 + 128 * u + (cc - 128)) + g16 * 4; orow0 = g16 * 4; }
    else { srcc = n0 + g16 * 4; orow0 = g16 * 4; }
    const bool valid = srcc < N;
    const float* wp = W + (size_t)(F.wave * TPW * 64 + 2 * kp) * N + (valid ? srcc : 0);
    f32x4 mx = (f32x4){0.f, 0.f, 0.f, 0.f};
#define C8_EMIT(x0, x1, tt) do { const int k0 = (F.wave * TPW + (tt)) * 64; \
        _Pragma("unroll") for (int i = 0; i < 8; ++i) { const int kk = 8 * i + 2 * kp; \
            _Pragma("unroll") for (int j = 0; j < 4; ++j) { const int q0 = (int)rintf(x0[i][j] * inv[j]), q1 = (int)rintf(x1[i][j] * inv[j]); \
                *(LAS unsigned short*)(T + (orow0 + ostep * j) * 80 + kk) = (unsigned short)((q0 & 255) | ((q1 & 255) << 8)); } } \
        LDS_WAIT(); asm volatile("" ::: "memory"); \
        _Pragma("unroll") for (int jj = 0; jj < 4; ++jj) { const int n = (lane >> 2) + 16 * jj, c = lane & 3; \
            *(u32x4*)(B8 + (size_t)(n0 + n) * K + k0 + 16 * c) = *(const LAS u32x4*)(T + n * 80 + c * 16); } \
        LDS_WAIT(); asm volatile("" ::: "memory"); } while (0)
#define C8_LOAD(x0, x1, tt) do { _Pragma("unroll") for (int i = 0; i < 8; ++i) { x0[i] = *(const f32x4*)(wp + (size_t)((tt) * 64 + 8 * i) * N); x1[i] = *(const f32x4*)(wp + (size_t)((tt) * 64 + 8 * i + 1) * N); } } while (0)
#define C8_MAX(x0, x1) do { _Pragma("unroll") for (int i = 0; i < 8; ++i) _Pragma("unroll") for (int j = 0; j < 4; ++j) mx[j] = fmaxf(mx[j], fmaxf(fabsf(x0[i][j]), fabsf(x1[i][j]))); } while (0)
#define C8_REDUCE() do { if (!valid) mx = (f32x4){0.f, 0.f, 0.f, 0.f}; \
        _Pragma("unroll") for (int j = 0; j < 4; ++j) { mx[j] = fmaxf(mx[j], __shfl_xor(mx[j], 16)); mx[j] = fmaxf(mx[j], __shfl_xor(mx[j], 32)); } \
        if (kp == 0) { _Pragma("unroll") for (int j = 0; j < 4; ++j) cmax[F.wave * 64 + orow0 + ostep * j] = mx[j]; } \
        __syncthreads(); \
        _Pragma("unroll") for (int j = 0; j < 4; ++j) { float m = 0.f; \
            _Pragma("unroll") for (int w = 0; w < 8; ++w) m = fmaxf(m, cmax[w * 64 + orow0 + ostep * j]); \
            const float sc = m > 0.f ? m * (1.f / 127.f) : 1.f; inv[j] = valid ? 1.f / sc : 0.f; \
            if (F.wave == 0 && kp == 0) cs[n0 + orow0 + ostep * j] = sc; } } while (0)
    f32x4 inv;
    if constexpr (HOLD && TPW == 2) {
        f32x4 xa0[8], xa1[8], xb0[8], xb1[8];
        C8_LOAD(xa0, xa1, 0); C8_LOAD(xb0, xb1, 1);
        C8_MAX(xa0, xa1); C8_MAX(xb0, xb1);
        C8_REDUCE();
        C8_EMIT(xa0, xa1, 0); C8_EMIT(xb0, xb1, 1);
    } else {
#pragma clang loop unroll(disable)
        for (int t = 0; t < TPW; ++t) { f32x4 x0[8], x1[8]; C8_LOAD(x0, x1, t); C8_MAX(x0, x1); }
        C8_REDUCE();
#pragma clang loop unroll(disable)
        for (int t = 0; t < TPW; ++t) { f32x4 x0[8], x1[8]; C8_LOAD(x0, x1, t); C8_EMIT(x0, x1, t); }
    }
    __syncthreads();
#undef C8_EMIT
#undef C8_LOAD
#undef C8_MAX
#undef C8_REDUCE
}
template <int TPW, bool HOLD>
__device__ __forceinline__ void conv8_job(Frame& F, int& base, const float* W, signed char* B8, float* cs, int K, int N, int nOut, int kind, int count, size_t wstride) {
    const int per = nOut / 64, tot = per * count;
    int it = F.vcu - (base % F.G); if (it < 0) it += F.G;
    for (; it < tot; it += F.G) { const int mi = it / per, nb = it % per;
        conv8_item<TPW, HOLD>(F, W + (size_t)mi * wstride, K, N, B8 + (size_t)mi * nOut * K, cs + (size_t)mi * nOut, nb * 64, kind); }
    base += tot;
}
__device__ __forceinline__ float wave_max(float v) {
#pragma unroll
    for (int o = 1; o < 64; o <<= 1) v = fmaxf(v, __shfl_xor(v, o));
    return v;
}
__device__ __forceinline__ unsigned pack_i8x4(float a, float b, float c, float d) { return ((unsigned)(int)rintf(a) & 255u) | (((unsigned)(int)rintf(b) & 255u) << 8) | (((unsigned)(int)rintf(c) & 255u) << 16) | ((unsigned)(int)rintf(d) << 24); }
__device__ __forceinline__ void quant_row_store(const f32x4 (&a)[4], signed char* h8row, float* hsp, int lane) {
    float m = 0.f;
#pragma unroll
    for (int j = 0; j < 4; ++j) m = fmaxf(m, fmaxf(fmaxf(fabsf(a[j].x), fabsf(a[j].y)), fmaxf(fabsf(a[j].z), fabsf(a[j].w))));
    m = wave_max(m);
    const float sc = m > 0.f ? m * (1.f / 127.f) : 1.f, inv = 1.f / sc;
#pragma unroll
    for (int j = 0; j < 4; ++j) *(unsigned*)(h8row + 4 * lane + 256 * j) = pack_i8x4(a[j].x * inv, a[j].y * inv, a[j].z * inv, a[j].w * inv);
    if (lane == 0) *hsp = sc;
}

__device__ __forceinline__ void mod_vectors(Frame& F, const float* c, const float* c_ctx, const float* ada_w, const float* ada_b, float* MOD) {
    LAS float* sc = (LAS float*)F.lds;
    LAS float* red = (LAS float*)(F.lds + 40960);
    bool loaded = false;
    for (int item = F.vcu; item < 96; item += F.G) {
        if (!loaded) { for (int i = F.tid; i < 9 * 1024; i += NTHR) { const float v = (i < 8192) ? c[i] : c_ctx[i - 8192]; sc[i] = siluf(v); } loaded = true; __syncthreads(); }
        const int layer = item / 48, cb = item % 48, col = cb * 128 + (F.tid & 127), kq = F.tid >> 7;
        const float* W = ada_w + (size_t)layer * 1024 * 6144 + col;
        float a[9];
#pragma unroll
        for (int r = 0; r < 9; ++r) a[r] = 0.f;
        for (int k = kq * 256; k < kq * 256 + 256; ++k) { const float w = W[(size_t)k * 6144];
#pragma unroll
            for (int r = 0; r < 9; ++r) a[r] += sc[r * 1024 + k] * w; }
#pragma unroll
        for (int r = 0; r < 9; ++r) red[(kq * 9 + r) * 128 + (F.tid & 127)] = a[r];
        __syncthreads();
        for (int i = F.tid; i < 9 * 128; i += NTHR) { const int r = i >> 7, cc = i & 127; const float v = red[(0 * 9 + r) * 128 + cc] + red[(1 * 9 + r) * 128 + cc] + red[(2 * 9 + r) * 128 + cc] + red[(3 * 9 + r) * 128 + cc];
            MOD[((size_t)layer * 9 + r) * 6144 + cb * 128 + cc] = v + ada_b[layer * 6144 + cb * 128 + cc]; }
        __syncthreads();
    }
}
__device__ __forceinline__ void rope_tables(Frame& F, f32x2* tabr, f32x2* tabm) {
    const int gt = F.vcu * NTHR + F.tid, NGT = F.G * NTHR;
    for (int i = gt; i < 64 * 64 + 64 * 16; i += NGT) {
        if (i < 4096) { const int pos = i >> 6, f = i & 63; const float inv = powf(10000.f, -(float)(2 * f) / 128.f); const float ang = (float)pos * inv; tabr[i] = (f32x2){cosf(ang), sinf(ang)}; }
        else { const int j = i - 4096, pos = j >> 4, f = j & 15; const float inv = powf(10000.f, -(float)(2 * f) / 32.f); const float ang = (float)pos * inv; tabm[j] = (f32x2){cosf(ang), sinf(ang)}; }
    }
}

__device__ __forceinline__ void norm_mod_row(const float* xrow, const float* g, const float* shift, const float* scale, bf16_t* orow, signed char* h8row, float* hsp, int lane) {
    const f32x4* xr = (const f32x4*)xrow + lane;
    f32x4 v[4]; float s = 0.f;
#pragma unroll
    for (int j = 0; j < 4; ++j) { v[j] = xr[64 * j]; s += (v[j].x * v[j].x + v[j].y * v[j].y) + (v[j].z * v[j].z + v[j].w * v[j].w); }
    const float rinv = rsqrtf(wave_sum(s) * (1.f / DM) + EPS);
#pragma unroll
    for (int j = 0; j < 4; ++j) {
        const f32x4 gg = ((const f32x4*)g)[lane + 64 * j], sh = ((const f32x4*)shift)[lane + 64 * j], sc = ((const f32x4*)scale)[lane + 64 * j];
        v[j].x = v[j].x * rinv * gg.x * (1.f + sc.x) + sh.x; v[j].y = v[j].y * rinv * gg.y * (1.f + sc.y) + sh.y;
        v[j].z = v[j].z * rinv * gg.z * (1.f + sc.z) + sh.z; v[j].w = v[j].w * rinv * gg.w * (1.f + sc.w) + sh.w;
        if (orow) ((unsigned long long*)orow)[lane + 64 * j] = (unsigned long long)cvt_pk_bf16(v[j].x, v[j].y) | ((unsigned long long)cvt_pk_bf16(v[j].z, v[j].w) << 32);
    }
    quant_row_store(v, h8row, hsp, lane);
}
__device__ __forceinline__ void norm_mod_row_b(const u32x4 (&xw)[2], const float* g, const float* shift, const float* scale, bf16_t* orow, signed char* h8row, float* hsp, int lane) {
    f32x4 v[4]; float s = 0.f;
#pragma unroll
    for (int j = 0; j < 2; ++j) { const u32x4 w = xw[j];
        v[2 * j] = (f32x4){bflo(w.x), bfhi(w.x), bflo(w.y), bfhi(w.y)}; v[2 * j + 1] = (f32x4){bflo(w.z), bfhi(w.z), bflo(w.w), bfhi(w.w)}; }
#pragma unroll
    for (int j = 0; j < 4; ++j) s += (v[j].x * v[j].x + v[j].y * v[j].y) + (v[j].z * v[j].z + v[j].w * v[j].w);
    const float rinv = rsqrtf(wave_sum(s) * (1.f / DM) + EPS);
    float m = 0.f;
#pragma unroll
    for (int j = 0; j < 4; ++j) { const int idx = 2 * (lane + 64 * (j >> 1)) + (j & 1);
        const f32x4 gg = ((const f32x4*)g)[idx], sh = ((const f32x4*)shift)[idx], sc = ((const f32x4*)scale)[idx];
        v[j] = v[j] * rinv * gg * (sc + 1.f) + sh;
        m = fmaxf(m, fmaxf(fmaxf(fabsf(v[j].x), fabsf(v[j].y)), fmaxf(fabsf(v[j].z), fabsf(v[j].w)))); }
#pragma unroll
    for (int j = 0; j < 2; ++j) { u32x4 w; w.x = cvt_pk_bf16(v[2 * j].x, v[2 * j].y); w.y = cvt_pk_bf16(v[2 * j].z, v[2 * j].w); w.z = cvt_pk_bf16(v[2 * j + 1].x, v[2 * j + 1].y); w.w = cvt_pk_bf16(v[2 * j + 1].z, v[2 * j + 1].w);
        ((u32x4*)orow)[lane + 64 * j] = w; }
    m = wave_max(m);
    const float qs = m > 0.f ? m * (1.f / 127.f) : 1.f, inv = 1.f / qs;
#pragma unroll
    for (int j = 0; j < 2; ++j) { u32x2 q; q.x = pack_i8x4(v[2 * j].x * inv, v[2 * j].y * inv, v[2 * j].z * inv, v[2 * j].w * inv); q.y = pack_i8x4(v[2 * j + 1].x * inv, v[2 * j + 1].y * inv, v[2 * j + 1].z * inv, v[2 * j + 1].w * inv);
        ((u32x2*)h8row)[lane + 64 * j] = q; }
    if (lane == 0) *hsp = qs;
}
__device__ __forceinline__ int mod_row_of(int r) { return r < NLAT ? (r >> 12) : 8; }

__device__ __forceinline__ void norm_router_block(Frame& F, int layer, int t0, int ntb, const bf16_t* XB, const float* g, const float* MODL, const bf16_t* Wr, signed char* H8, float* HS, float* LOGIT) {
    constexpr int HP = 2064;
    char* ldsg = (char*)F.lds;
    LAS unsigned char* HT = F.lds; LAS float* PT = (LAS float*)(F.lds + 36864);
    const int lane = F.lane, w = F.wave, l15 = lane & 15, q4 = lane >> 4;
    bf16x8 wreg[4][4];
#pragma unroll
    for (int nt = 0; nt < 4; ++nt)
#pragma unroll
        for (int ks = 0; ks < 4; ++ks) wreg[nt][ks] = *(const bf16x8*)(Wr + (size_t)(16 * nt + l15) * DM + 128 * w + 32 * ks + 8 * q4);
    for (int b0 = 0; b0 < ntb; b0 += 16) {
        u32x4 xw[2][2];
#pragma unroll
        for (int i = 0; i < 2; ++i) { const int rb = b0 + 2 * w + i; if (rb < ntb) { const bf16_t* xr = XB + (size_t)(t0 + rb) * DM; xw[i][0] = ((const u32x4*)xr)[lane]; xw[i][1] = ((const u32x4*)xr)[lane + 64]; } }
#pragma unroll
        for (int i = 0; i < 2; ++i) { const int rb = b0 + 2 * w + i; if (rb < ntb) { const int r = t0 + rb; const float* md = MODL + (size_t)mod_row_of(r) * 6144;
            norm_mod_row_b(xw[i], g, md + 3 * 1024, md + 4 * 1024, (bf16_t*)(ldsg + (2 * w + i) * HP), H8 + (size_t)r * DM, HS + r, lane); } }
        __syncthreads();
        f32x4 acc[4];
#pragma unroll
        for (int nt = 0; nt < 4; ++nt) acc[nt] = (f32x4){0.f, 0.f, 0.f, 0.f};
#pragma unroll
        for (int ks = 0; ks < 4; ++ks) { const bf16x8 hf = *(const LAS bf16x8*)(HT + l15 * HP + (128 * w + 32 * ks + 8 * q4) * 2);
#pragma unroll
            for (int nt = 0; nt < 4; ++nt) acc[nt] = __builtin_amdgcn_mfma_f32_16x16x32_bf16(wreg[nt][ks], hf, acc[nt], 0, 0, 0); }
#pragma unroll
        for (int nt = 0; nt < 4; ++nt) *(LAS f32x4*)(PT + (w * 16 + l15) * 64 + 16 * nt + 4 * q4) = acc[nt];
        __syncthreads();
        { const int row = F.tid >> 5, e2 = (F.tid & 31) * 2; f32x2 s = (f32x2){0.f, 0.f};
#pragma unroll
          for (int ww = 0; ww < 8; ++ww) { const f32x2 p = *(const LAS f32x2*)(PT + (ww * 16 + row) * 64 + e2); s.x += p.x; s.y += p.y; }
          if (b0 + row < ntb) *(f32x2*)(LOGIT + (size_t)(t0 + b0 + row) * 64 + e2) = s; }
    }
    __syncthreads();
}


struct EpiRetProj {
    static constexpr int PERM = 2;
    bf16_t* QK; bf16_t* V; bf16_t* Gt; const f32x4* tab;
    __device__ __forceinline__ void operator()(const f32x4 (&acc)[2][2][4][2], const g8::Unit& u, int wr, int wc, int fr, int fq) const {
        const int col0 = u.col0; bf16_t* base; int ldc, cc;
        if (col0 < 2048) { base = QK; ldc = 2048; cc = col0; } else if (col0 < 4096) { base = V; ldc = 2048; cc = col0 - 2048; } else { base = Gt; ldc = 4096; cc = col0 - 4096; }
        const bool isqk = col0 < 2048, rope = isqk && (u.row0 < NLAT);
        const float sc = (col0 >= 1024 && col0 < 2048) ? 0.0625f : 1.f;
        const int axis = wc >> 1, i0 = (64 * (wc & 1) + 16 * fq) >> 1;
#pragma unroll
        for (int ai = 0; ai < 2; ++ai)
#pragma unroll
            for (int m = 0; m < 4; ++m) {
                const int r = u.row0 + ai * 128 + wr * 64 + m * 16 + fr;
                bf16_t* rowp = base + (size_t)r * ldc + cc + wc * 64 + 16 * fq;
                const int s = r & 4095;
                u32x4 w[2];
#pragma unroll
                for (int bj = 0; bj < 2; ++bj) {
                    f32x4 v0 = acc[ai][bj][m][0], v1 = acc[ai][bj][m][1];
                    if (rope) {
                        const int pos = axis == 0 ? (s >> 6) : (s & 63);
                        const f32x4* tp = tab + ((pos * 64 + i0 + 4 * bj) >> 1);
                        const f32x4 t0 = tp[0], t1 = tp[1];
                        f32x4 o0, o1;
                        o0.x = v0.x * t0.x - v0.y * t0.y; o0.y = v0.y * t0.x + v0.x * t0.y; o0.z = v0.z * t0.z - v0.w * t0.w; o0.w = v0.w * t0.z + v0.z * t0.w;
                        o1.x = v1.x * t1.x - v1.y * t1.y; o1.y = v1.y * t1.x + v1.x * t1.y; o1.z = v1.z * t1.z - v1.w * t1.w; o1.w = v1.w * t1.z + v1.z * t1.w;
                        v0 = o0; v1 = o1;
                    }
                    v0 = v0 * sc; v1 = v1 * sc;
                    w[bj].x = cvt_pk_bf16(v0.x, v0.y); w[bj].y = cvt_pk_bf16(v0.z, v0.w); w[bj].z = cvt_pk_bf16(v1.x, v1.y); w[bj].w = cvt_pk_bf16(v1.z, v1.w);
                }
                if (col0 < 4096) { *(u32x4*)rowp = w[0]; *(u32x4*)(rowp + 8) = w[1]; }
                else {
                    u32x4 g8;
#pragma unroll
                    for (int bj = 0; bj < 2; ++bj)
#pragma unroll
                        for (int n = 0; n < 2; ++n) { f32x4 v = acc[ai][bj][m][n];
#pragma unroll
                            for (int j = 0; j < 4; ++j) v[j] = __builtin_amdgcn_fmed3f(v[j], -448.f, 448.f);
                            int p = 0; p = __builtin_amdgcn_cvt_pk_fp8_f32(v.x, v.y, p, false); p = __builtin_amdgcn_cvt_pk_fp8_f32(v.z, v.w, p, true); g8[bj * 2 + n] = (unsigned)p; }
                    *(u32x4*)((unsigned char*)Gt + (size_t)r * 4096 + cc + wc * 64 + 16 * fq) = g8;
                }
            }
    }
};
template <bool INBF> struct EpiResid {
    static constexpr int PERM = 1;
    const float* xin_l; const float* xin_c; bf16_t* xb; const float* gate;
    __device__ __forceinline__ void operator()(const f32x4 (&acc)[2][2][4][2], const g8::Unit& u, int wr, int wc, int fr, int fq) const {
        const bool lat = u.row0 < NLAT;
        const int cofs = u.col0 + wc * 32 + 8 * fq;
        const float* gin = gate + (size_t)(lat ? (u.row0 >> 12) : 8) * 6144 + cofs;
        f32x4 gv[2][2];
#pragma unroll
        for (int bj = 0; bj < 2; ++bj)
#pragma unroll
            for (int n = 0; n < 2; ++n) gv[bj][n] = *(const f32x4*)(gin + bj * 128 + n * 4);
#pragma unroll
        for (int ai = 0; ai < 2; ++ai)
#pragma unroll
            for (int m = 0; m < 4; ++m) {
                const int r = u.row0 + ai * 128 + wr * 64 + m * 16 + fr;
                bf16_t* op = xb + (size_t)r * DM + cofs;
                const float* ip = (lat ? xin_l + (size_t)r * DM : xin_c + (size_t)(r - NLAT) * DM) + cofs;
#pragma unroll
                for (int bj = 0; bj < 2; ++bj) {
                    f32x4 x0, x1;
                    if constexpr (INBF) { const u32x4 w = *(const u32x4*)(op + bj * 128); x0 = (f32x4){bflo(w.x), bfhi(w.x), bflo(w.y), bfhi(w.y)}; x1 = (f32x4){bflo(w.z), bfhi(w.z), bflo(w.w), bfhi(w.w)}; }
                    else { x0 = *(const f32x4*)(ip + bj * 128); x1 = *(const f32x4*)(ip + bj * 128 + 4); }
                    x0 += gv[bj][0] * acc[ai][bj][m][0]; x1 += gv[bj][1] * acc[ai][bj][m][1];
                    u32x4 w; w.x = cvt_pk_bf16(x0.x, x0.y); w.y = cvt_pk_bf16(x0.z, x0.w); w.z = cvt_pk_bf16(x1.x, x1.y); w.w = cvt_pk_bf16(x1.z, x1.w);
                    *(u32x4*)(op + bj * 128) = w; }
            }
    }
};

struct EpiLogits {
    static constexpr int PERM = 0;
    float* L;
    __device__ __forceinline__ void operator()(const f32x4 (&acc)[2][2][4][2], const g8::Unit& u, int wr, int wc, int fr, int fq) const {
        if (wc >= 2) return;
#pragma unroll
        for (int ai = 0; ai < 2; ++ai)
#pragma unroll
            for (int m = 0; m < 4; ++m) { float* rp = L + (size_t)(u.row0 + ai * 128 + wr * 64 + m * 16 + fr) * 64 + wc * 32 + 4 * fq;
#pragma unroll
                for (int n = 0; n < 2; ++n) *(f32x4*)(rp + n * 16) = acc[ai][0][m][n]; }
    }
};
struct EpiAct {
    static constexpr int PERM = 1;
    bf16_t* ACT;
    __device__ __forceinline__ void operator()(const f32x4 (&acc)[2][2][4][2], const g8::Unit& u, int wr, int wc, int fr, int fq) const {
#pragma unroll
        for (int ai = 0; ai < 2; ++ai)
#pragma unroll
            for (int m = 0; m < 4; ++m) {
                bf16_t* rp = ACT + (size_t)(u.row0 + ai * 128 + wr * 64 + m * 16 + fr) * 256 + (u.col0 >> 1) + wc * 32 + 8 * fq;
                const f32x4 g0 = acc[ai][0][m][0], g1 = acc[ai][0][m][1], u0 = acc[ai][1][m][0], u1 = acc[ai][1][m][1];
                u32x4 w; w.x = cvt_pk_bf16(siluf(g0.x) * u0.x, siluf(g0.y) * u0.y); w.y = cvt_pk_bf16(siluf(g0.z) * u0.z, siluf(g0.w) * u0.w);
                w.z = cvt_pk_bf16(siluf(g1.x) * u1.x, siluf(g1.y) * u1.y); w.w = cvt_pk_bf16(siluf(g1.z) * u1.z, siluf(g1.w) * u1.w);
                *(u32x4*)rp = w;
            }
    }
};
constexpr float YS_SCALE = 32.f;
struct EpiDown {
    static constexpr int PERM = 2;
    unsigned char* YS;
    __device__ __forceinline__ void operator()(const f32x4 (&acc)[2][2][4][2], const g8::Unit& u, int wr, int wc, int fr, int fq) const {
#pragma unroll
        for (int ai = 0; ai < 2; ++ai)
#pragma unroll
            for (int m = 0; m < 4; ++m) {
                const int r = ai * 128 + wr * 64 + m * 16 + fr;
                const float wt = YS_SCALE;
                u32x4 w;
#pragma unroll
                for (int bj = 0; bj < 2; ++bj)
#pragma unroll
                    for (int n = 0; n < 2; ++n) { f32x4 v = acc[ai][bj][m][n] * wt;
#pragma unroll
                        for (int j = 0; j < 4; ++j) v[j] = __builtin_amdgcn_fmed3f(v[j], -448.f, 448.f);
                        int p = 0; p = __builtin_amdgcn_cvt_pk_fp8_f32(v.x, v.y, p, false); p = __builtin_amdgcn_cvt_pk_fp8_f32(v.z, v.w, p, true); w[bj * 2 + n] = (unsigned)p; }
                *(u32x4*)(YS + (size_t)(u.row0 + r) * 1024 + u.col0 + wc * 64 + 16 * fq) = w;
            }
    }
};

namespace g8 { template <> struct epi_nst<EpiRetProj> { static constexpr int value = 8; }; template <bool B> struct epi_nst<EpiResid<B>> { static constexpr int value = 16; };
               template <> struct epi_nst<EpiAct> { static constexpr int value = 8; }; template <> struct epi_nst<EpiDown> { static constexpr int value = 8; }; }

constexpr int LDS_TPRE = LDSCTL_OFF + 1024, LDS_CNTS = LDSCTL_OFF + 2048;
__device__ __forceinline__ void build_tpre(Frame& F, int layer, int ntok) {
    LAS int* tpre = (LAS int*)(F.lds + LDS_TPRE); LAS int* cnts = (LAS int*)(F.lds + LDS_CNTS);
    __syncthreads();
    if (F.tid < 64) {
        const int cn = (int)__hip_atomic_load(F.ctl + CW_CNT + (layer * 64 + F.tid) * 16, __ATOMIC_RELAXED, __HIP_MEMORY_SCOPE_AGENT);
        int t = (cn + 255) >> 8, inc = t;
#pragma unroll
        for (int o = 1; o < 64; o <<= 1) { const int v = __shfl_up(inc, o); if (F.lane >= o) inc += v; }
        cnts[F.tid] = cn; tpre[F.tid + 1] = inc; if (F.tid == 0) tpre[0] = 0;
        if (F.tid == 63) { cnts[64] = ntok; tpre[65] = inc + (ntok >> 8); }
    }
    __syncthreads();
}
__device__ __forceinline__ void route_block(Frame& F, int layer, int t0, int ntb, const float* logits, const float* bias, int* LIST, float* RTW, int* RTP, const float* HS, float* LISTS) {
    LAS int* lcnt = (LAS int*)F.lds; LAS int* gbase = lcnt + 64; LAS int* rec_e = lcnt + 128; LAS float* rec_w = (LAS float*)(rec_e + 2048);
    const int lane = F.lane;
    if (F.tid < 64) lcnt[F.tid] = 0;
    __syncthreads();
    const float bl = bias[lane];
    for (int tl0 = F.wave; tl0 < ntb; tl0 += 4 * NWAVES) {
        constexpr int TT = 4;
        float s[TT], sel[TT], m1[TT], m2[TT], gs[TT], v[TT], ssum[TT]; int i1[TT], grank[TT], rank[TT]; bool ok[TT];
#pragma unroll
        for (int u = 0; u < TT; ++u) { const int tl = tl0 + u * NWAVES; ok[u] = tl < ntb; const int tq = ok[u] ? tl : tl0;
            s[u] = __builtin_amdgcn_rcpf(1.f + __expf(-logits[(size_t)(t0 + tq) * 64 + lane])); sel[u] = s[u] + bl; m1[u] = sel[u]; }
#pragma unroll
        for (int o = 1; o < 8; o <<= 1)
#pragma unroll
            for (int u = 0; u < TT; ++u) m1[u] = fmaxf(m1[u], __shfl_xor(m1[u], o));
#pragma unroll
        for (int u = 0; u < TT; ++u) i1[u] = (sel[u] == m1[u]) ? lane : 64;
#pragma unroll
        for (int o = 1; o < 8; o <<= 1)
#pragma unroll
            for (int u = 0; u < TT; ++u) i1[u] = min(i1[u], __shfl_xor(i1[u], o));
#pragma unroll
        for (int u = 0; u < TT; ++u) m2[u] = (lane == i1[u]) ? -INFINITY : sel[u];
#pragma unroll
        for (int o = 1; o < 8; o <<= 1)
#pragma unroll
            for (int u = 0; u < TT; ++u) m2[u] = fmaxf(m2[u], __shfl_xor(m2[u], o));
        const int g = lane >> 3;
#pragma unroll
        for (int u = 0; u < TT; ++u) { gs[u] = m1[u] + m2[u]; grank[u] = 0; }
#pragma unroll
        for (int gg = 0; gg < 8; ++gg)
#pragma unroll
            for (int u = 0; u < TT; ++u) { const float o = __builtin_bit_cast(float, __builtin_amdgcn_readlane(__builtin_bit_cast(int, gs[u]), gg * 8)); grank[u] += (o > gs[u] || (o == gs[u] && gg < g)) ? 1 : 0; }
#pragma unroll
        for (int u = 0; u < TT; ++u) { v[u] = grank[u] < 4 ? sel[u] : -INFINITY; rank[u] = 0; }
#pragma unroll
        for (int l = 0; l < 64; ++l)
#pragma unroll
            for (int u = 0; u < TT; ++u) { const float o = __builtin_bit_cast(float, __builtin_amdgcn_readlane(__builtin_bit_cast(int, v[u]), l)); rank[u] += (o > v[u] || (o == v[u] && l < lane)) ? 1 : 0; }
#pragma unroll
        for (int u = 0; u < TT; ++u) ssum[u] = (rank[u] < 8) ? s[u] : 0.f;
#pragma unroll
        for (int o = 1; o < 64; o <<= 1)
#pragma unroll
            for (int u = 0; u < TT; ++u) ssum[u] += __shfl_xor(ssum[u], o);
#pragma unroll
        for (int u = 0; u < TT; ++u) {
            if (ok[u] && rank[u] < 8) { const int tl = tl0 + u * NWAVES;
                const int lp = __hip_atomic_fetch_add(lcnt + lane, 1, __ATOMIC_RELAXED, __HIP_MEMORY_SCOPE_WORKGROUP);
                rec_e[tl * 8 + rank[u]] = (lane << 20) | lp; rec_w[tl * 8 + rank[u]] = s[u] / ssum[u] * 2.5f; }
        }
    }
    __syncthreads();
    if (F.tid < 64) gbase[F.tid] = (int)__hip_atomic_fetch_add(F.ctl + CW_CNT + (layer * 64 + F.tid) * 16, (unsigned)lcnt[F.tid], __ATOMIC_RELAXED, __HIP_MEMORY_SCOPE_AGENT);
    __syncthreads();
    for (int i = F.tid; i < ntb * 8; i += NTHR) {
        const int el = rec_e[i], e = el >> 20, p = gbase[e] + (el & 0xfffff), t = t0 + (i >> 3);
        LIST[(size_t)e * NT + p] = t; LISTS[(size_t)e * NT + p] = HS[t]; RTP[(size_t)t * 8 + (i & 7)] = (e << 20) | p; RTW[(size_t)t * 8 + (i & 7)] = rec_w[i];
    }
    __syncthreads();
}
template <bool OUTF32> __device__ __forceinline__ void combine_row(Frame& F, const int* RTP, const float* RTW, int t, const unsigned char* YS, const bf16_t* xrow, float* xof, bf16_t* xob, const float* gate, bool donorm, const float* g, const float* shift, const float* scale, signed char* h8row, float* hsp) {
    const LAS int* tpre = (const LAS int*)(F.lds + LDS_TPRE);
    const int lane = F.lane;
    int ep[8];
#pragma unroll
    for (int k = 0; k < 8; ++k) ep[k] = RTP[(size_t)t * 8 + k];
    u32x4 yv[9];
#pragma unroll
    for (int k = 0; k < 9; ++k) {
        const size_t pos = k < 8 ? (size_t)tpre[ep[k < 8 ? k : 0] >> 20] * 256 + (ep[k < 8 ? k : 0] & 0xfffff) : (size_t)tpre[64] * 256 + t;
        yv[k] = *(const u32x4*)(YS + pos * 1024 + 16 * lane);
    }
    f32x4 xi[4];
#pragma unroll
    for (int j = 0; j < 2; ++j) { const u32x4 w = ((const u32x4*)xrow)[2 * lane + j];
        xi[2 * j] = (f32x4){bflo(w.x), bfhi(w.x), bflo(w.y), bfhi(w.y)}; xi[2 * j + 1] = (f32x4){bflo(w.z), bfhi(w.z), bflo(w.w), bfhi(w.w)}; }
    f32x4 a[4];
#pragma unroll
    for (int j = 0; j < 4; ++j) a[j] = (f32x4){0.f, 0.f, 0.f, 0.f};
#pragma unroll
    for (int k = 0; k < 9; ++k) { const float wk = k < 8 ? RTW[(size_t)t * 8 + (k < 8 ? k : 0)] : 1.f;
#pragma unroll
        for (int j = 0; j < 4; ++j) { const f32x2 lo = __builtin_amdgcn_cvt_pk_f32_fp8((int)yv[k][j], false), hi = __builtin_amdgcn_cvt_pk_f32_fp8((int)yv[k][j], true);
            a[j].x += wk * lo.x; a[j].y += wk * lo.y; a[j].z += wk * hi.x; a[j].w += wk * hi.y; } }
    f32x4 v[4]; float ss = 0.f;
#pragma unroll
    for (int j = 0; j < 4; ++j) { const f32x4 gg = *(const f32x4*)(gate + 16 * lane + 4 * j);
        v[j] = xi[j] + gg * a[j] * (1.f / YS_SCALE);
        if constexpr (OUTF32) *(f32x4*)(xof + 16 * lane + 4 * j) = v[j];
        ss += (v[j].x * v[j].x + v[j].y * v[j].y) + (v[j].z * v[j].z + v[j].w * v[j].w); }
    if constexpr (!OUTF32) {
#pragma unroll
        for (int j = 0; j < 2; ++j) { u32x4 w; w.x = cvt_pk_bf16(v[2 * j].x, v[2 * j].y); w.y = cvt_pk_bf16(v[2 * j].z, v[2 * j].w); w.z = cvt_pk_bf16(v[2 * j + 1].x, v[2 * j + 1].y); w.w = cvt_pk_bf16(v[2 * j + 1].z, v[2 * j + 1].w);
            ((u32x4*)xob)[2 * lane + j] = w; }
    }
    if (donorm) {
        const float rinv = rsqrtf(wave_sum(ss) * (1.f / DM) + EPS);
        float m = 0.f;
#pragma unroll
        for (int j = 0; j < 4; ++j) {
            const f32x4 gg = *(const f32x4*)(g + 16 * lane + 4 * j), sh = *(const f32x4*)(shift + 16 * lane + 4 * j), sc = *(const f32x4*)(scale + 16 * lane + 4 * j);
            v[j] = v[j] * rinv * gg * (sc + 1.f) + sh;
            m = fmaxf(m, fmaxf(fmaxf(fabsf(v[j].x), fabsf(v[j].y)), fmaxf(fabsf(v[j].z), fabsf(v[j].w))));
        }
        m = wave_max(m);
        const float qs = m > 0.f ? m * (1.f / 127.f) : 1.f, inv = 1.f / qs;
        u32x4 q;
#pragma unroll
        for (int j = 0; j < 4; ++j) q[j] = pack_i8x4(v[j].x * inv, v[j].y * inv, v[j].z * inv, v[j].w * inv);
        *(u32x4*)(h8row + 16 * lane) = q;
        if (lane == 0) *hsp = qs;
    }
}

struct EpiStore {
    static constexpr int PERM = 1;
    bf16_t* O; int ldc;
    __device__ __forceinline__ void operator()(const f32x4 (&acc)[2][2][4][2], const g8::Unit& u, int wr, int wc, int fr, int fq) const {
#pragma unroll
        for (int ai = 0; ai < 2; ++ai)
#pragma unroll
            for (int m = 0; m < 4; ++m) {
                bf16_t* rp = O + (size_t)(u.row0 + ai * 128 + wr * 64 + m * 16 + fr) * ldc + u.col0 + wc * 32 + 8 * fq;
#pragma unroll
                for (int bj = 0; bj < 2; ++bj) { const f32x4 v0 = acc[ai][bj][m][0], v1 = acc[ai][bj][m][1];
                    u32x4 w; w.x = cvt_pk_bf16(v0.x, v0.y); w.y = cvt_pk_bf16(v0.z, v0.w); w.z = cvt_pk_bf16(v1.x, v1.y); w.w = cvt_pk_bf16(v1.z, v1.w);
                    *(u32x4*)(rp + bj * 128) = w; }
            }
    }
};

namespace g8 { template <> struct epi_nst<EpiStore> { static constexpr int value = 16; }; }

__device__ __forceinline__ void mla_final_row(int r, const bf16_t* A, const bf16_t* QRAW, const bf16_t* KVRAW, const float* qnorm, const float* knorm, const f32x2* tabm, signed char* QF, signed char* KF, bf16_t* VF, int lane) {
    const bool lat = r < NLAT;
    const int b = lat ? (r >> 12) : ((r - NLAT) >> 8), s = lat ? (r & 4095) : 0, kidx = lat ? s : 4096 + ((r - NLAT) & 255);
    constexpr float QKS = 127.f / 8.f;
    unsigned qw[8], kw[8], vw[8], aq[3]; bf16_t qrp[8];
    const bf16_t* kvr = KVRAW + (size_t)r * 2048; const bf16_t* ar = A + (size_t)r * 768;
#pragma unroll
    for (int h = 0; h < 8; ++h) { kw[h] = *(const unsigned*)(kvr + h * 256 + 2 * lane); vw[h] = *(const unsigned*)(kvr + h * 256 + 128 + 2 * lane); }
    const u32x2 akv = *(const u32x2*)(ar + 384 + 4 * lane); const float akr = bf2f(ar[640 + lane]);
    if (lat) {
        const bf16_t* qrw = QRAW + (size_t)r * 1536;
#pragma unroll
        for (int h = 0; h < 8; ++h) { qw[h] = *(const unsigned*)(qrw + h * 192 + 2 * lane); qrp[h] = qrw[h * 192 + 128 + lane]; }
#pragma unroll
        for (int j = 0; j < 3; ++j) aq[j] = *(const unsigned*)(ar + 128 * j + 2 * lane);
    }
    const f32x2 gq = *(const f32x2*)(qnorm + 2 * lane), gk = *(const f32x2*)(knorm + 2 * lane); const float gqr = qnorm[128 + lane], gkr = knorm[128 + lane];
    const int a = lane >> 5, t = (lane >> 4) & 1, i = lane & 15, pos = a == 0 ? (s >> 6) : (s & 63);
    const f32x2 cs = tabm[pos * 16 + i];
    float sk[8], sq[8], sr[8];
    float skv = bflo(akv.x) * bflo(akv.x) + bfhi(akv.x) * bfhi(akv.x) + bflo(akv.y) * bflo(akv.y) + bfhi(akv.y) * bfhi(akv.y), skr = akr * akr, saq = 0.f;
#pragma unroll
    for (int h = 0; h < 8; ++h) { const float k0 = bflo(kw[h]), k1 = bfhi(kw[h]); sk[h] = k0 * k0 + k1 * k1; }
    if (lat) {
#pragma unroll
        for (int h = 0; h < 8; ++h) { const float q0 = bflo(qw[h]), q1 = bfhi(qw[h]), qr_ = bf2f(qrp[h]); sq[h] = q0 * q0 + q1 * q1; sr[h] = qr_ * qr_; }
#pragma unroll
        for (int j = 0; j < 3; ++j) saq += bflo(aq[j]) * bflo(aq[j]) + bfhi(aq[j]) * bfhi(aq[j]);
    }
#pragma unroll
    for (int o = 1; o < 64; o <<= 1) {
#pragma unroll
        for (int h = 0; h < 8; ++h) sk[h] += __shfl_xor(sk[h], o);
        skv += __shfl_xor(skv, o); skr += __shfl_xor(skr, o);
        if (lat) {
#pragma unroll
            for (int h = 0; h < 8; ++h) { sq[h] += __shfl_xor(sq[h], o); sr[h] += __shfl_xor(sr[h], o); }
            saq += __shfl_xor(saq, o);
        }
    }
    const float rkv = rsqrtf(skv * (1.f / 256.f) + EPS), rkv2 = rkv * rkv;
    const float rqa = lat ? rsqrtf(saq * (1.f / 384.f) + EPS) : 1.f, rqa2 = rqa * rqa;
    float krn = akr * rsqrtf(skr * (1.f / 64.f) + EPS) * gkr;
    { const float pr = __shfl_xor(krn, 16); if (lat) krn = krn * cs.x + (t ? pr * cs.y : -pr * cs.y); }
    const int kr8 = (int)rintf(__builtin_amdgcn_fmed3f(krn * QKS, -127.f, 127.f));
#pragma unroll
    for (int h = 0; h < 8; ++h) {
        const size_t kvo = (size_t)(b * 8 + h) * SKV + kidx;
        const float rinv = rkv * rsqrtf(rkv2 * sk[h] * (1.f / 128.f) + EPS) * QKS;
        signed char* ko = KF + kvo * 192;
        { const int k0 = (int)rintf(__builtin_amdgcn_fmed3f(bflo(kw[h]) * rinv * gk.x, -127.f, 127.f)), k1 = (int)rintf(__builtin_amdgcn_fmed3f(bfhi(kw[h]) * rinv * gk.y, -127.f, 127.f));
          *(unsigned short*)(ko + 2 * lane) = (unsigned short)((k0 & 255) | ((k1 & 255) << 8)); }
        ko[128 + lane] = (signed char)kr8;
        *(unsigned*)(VF + kvo * 128 + 2 * lane) = cvt_pk_bf16(bflo(vw[h]) * rkv, bfhi(vw[h]) * rkv);
        if (lat) {
            const float rq = rqa * rsqrtf(rqa2 * sq[h] * (1.f / 128.f) + EPS) * QKS, rr = rqa * rsqrtf(rqa2 * sr[h] * (1.f / 64.f) + EPS);
            signed char* qo = QF + ((size_t)(b * 8 + h) * 4096 + s) * 192;
            { const int q0 = (int)rintf(__builtin_amdgcn_fmed3f(bflo(qw[h]) * rq * gq.x, -127.f, 127.f)), q1 = (int)rintf(__builtin_amdgcn_fmed3f(bfhi(qw[h]) * rq * gq.y, -127.f, 127.f));
              *(unsigned short*)(qo + 2 * lane) = (unsigned short)((q0 & 255) | ((q1 & 255) << 8)); }
            float vn = bf2f(qrp[h]) * rr * gqr; const float pr = __shfl_xor(vn, 16);
            vn = vn * cs.x + (t ? pr * cs.y : -pr * cs.y);
            qo[128 + lane] = (signed char)(int)rintf(__builtin_amdgcn_fmed3f(vn * QKS, -127.f, 127.f));
        }
    }
}

namespace att {
constexpr int NW = 8, QBLK = 32, KVBLK = 64, DQ = 192, DV = 128;
constexpr int KROW = 208;
constexpr int SHM_V = KVBLK * DV * 2, SHM_K = KVBLK * KROW;
constexpr int K_OFF = 3 * SHM_V, WS_OFF = K_OFF + 3 * SHM_K;
constexpr float THRL = 11.5f;
constexpr float SC = 0.07216878364870322f * 1.4426950408889634f / (15.875f * 15.875f);
constexpr float MAGIC = 12582912.f;
typedef int i32x16 __attribute__((ext_vector_type(16)));
#define SBAR() __builtin_amdgcn_sched_barrier(0)
#define MF8(A, B, C) __builtin_amdgcn_mfma_i32_32x32x32_i8((A), (B), (C), 0, 0, 0)
#define MFB(A, B, C) __builtin_amdgcn_mfma_f32_32x32x16_bf16((A), (B), (C), 0, 0, 0)
#define EX2(x) __builtin_amdgcn_exp2f(x)
__device__ __forceinline__ int crow(int r, int hi) { return (r & 3) + 8 * (r >> 2) + 4 * hi; }
__device__ __forceinline__ int v_st(int k, int c) { const int kk = (k & ~0xC) | ((k & 4) << 1) | ((k & 8) >> 1); return ((kk >> 3) * 4 + (c >> 5)) * 512 + ((kk & 7) * 32 + (c & 31)) * 2; }
__device__ __forceinline__ int v_rd_base(int lane) { return ((lane & 3) << 3) | (((lane >> 2) & 3) << 6) | (((lane >> 4) & 1) << 5) | (((lane >> 5) & 1) << 8); }
constexpr int v_rd_off(int d0, int ks, int half) { return d0 * 512 + ks * 4096 + half * 2048; }
typedef short v4i16_t __attribute__((ext_vector_type(4)));
__device__ __forceinline__ bf16x8 vfrag(const LAS unsigned char* p, int off) {
    const s16x4 l = __builtin_bit_cast(s16x4, __builtin_amdgcn_ds_read_tr16_b64_v4i16((LAS v4i16_t*)(p + off)));
    const s16x4 h = __builtin_bit_cast(s16x4, __builtin_amdgcn_ds_read_tr16_b64_v4i16((LAS v4i16_t*)(p + off + 2048)));
    return (bf16x8){l[0], l[1], l[2], l[3], h[0], h[1], h[2], h[3]};
}
#define EXP4(P, R) do { P[R] = EX2(P[R]); P[(R) + 1] = EX2(P[(R) + 1]); P[(R) + 2] = EX2(P[(R) + 2]); P[(R) + 3] = EX2(P[(R) + 3]); } while (0)
#define EXP3(P, R) do { P[R] = EX2(P[R]); P[(R) + 1] = EX2(P[(R) + 1]); P[(R) + 2] = EX2(P[(R) + 2]); } while (0)
#define ADD8(P, R) do { ps += P[R]; pt += P[(R) + 1]; ps += P[(R) + 2]; pt += P[(R) + 3]; ps += P[(R) + 4]; pt += P[(R) + 5]; ps += P[(R) + 6]; pt += P[(R) + 7]; } while (0)
#define MAX8(P, R) do { pm = fmaxf(fmaxf(pm, P[R]), P[(R) + 1]); pn = fmaxf(fmaxf(pn, P[(R) + 2]), P[(R) + 3]); pm = fmaxf(fmaxf(pm, P[(R) + 4]), P[(R) + 5]); pn = fmaxf(fmaxf(pn, P[(R) + 6]), P[(R) + 7]); } while (0)
#define FMA8(P, R) do { _Pragma("unroll") for (int _r = 0; _r < 8; ++_r) P[(R) + _r] = fmaf(P[(R) + _r], SC, mc); } while (0)
#define PK4(P, BASE, OUT) do { unsigned a0_ = cvt_pk_bf16(P[BASE + 0], P[BASE + 1]), a1_ = cvt_pk_bf16(P[BASE + 2], P[BASE + 3]);   \
    unsigned b0_ = cvt_pk_bf16(P[BASE + 4], P[BASE + 5]), b1_ = cvt_pk_bf16(P[BASE + 6], P[BASE + 7]);                              \
    auto r0_ = __builtin_amdgcn_permlane32_swap(a0_, b0_, false, false); auto r1_ = __builtin_amdgcn_permlane32_swap(a1_, b1_, false, false); \
    u32x4 w_ = {r0_[0], r1_[0], r0_[1], r1_[1]}; OUT = __builtin_bit_cast(bf16x8, w_); } while (0)
__device__ __forceinline__ void region1(f32x16& Y0, f32x16& Y1, f32x16& X0, f32x16& X1, float alX, float& l_reg, bf16x8& pa0, bf16x8& pa1, bf16x8& pa2, bf16x8& pa3,
                                        const char* kb, const i32x4* qr, const i32x16& mg) {
#define KF(i) (*reinterpret_cast<const i32x4*>(kb + ((i) & 1) * 32 * KROW + ((i) >> 1) * 32))
    i32x16 a0, a1; i32x4 f0 = KF(0), f1 = KF(1), f2 = KF(2);
    float ps = 0.f, pt = 0.f;
    EXP4(X1, 0); EXP4(X1, 4); SBAR();
    a0 = MF8(f0, qr[0], mg); f0 = KF(3); EXP4(X1, 8); SBAR();
    a1 = MF8(f1, qr[0], mg); f1 = KF(4); EXP4(X1, 12); SBAR();
    a0 = MF8(f2, qr[1], a0); f2 = KF(5); ADD8(X0, 0); SBAR();
    a1 = MF8(f0, qr[1], a1); f0 = KF(6); ADD8(X0, 8); SBAR();
    a0 = MF8(f1, qr[2], a0); f1 = KF(7); ADD8(X1, 0); SBAR();
    a1 = MF8(f2, qr[2], a1); f2 = KF(8); ADD8(X1, 8); SBAR();
    a0 = MF8(f0, qr[3], a0); f0 = KF(9);
    { ps += pt; auto rr = __builtin_amdgcn_permlane32_swap(__float_as_uint(ps), __float_as_uint(ps), false, false); ps = __uint_as_float(rr[0]) + __uint_as_float(rr[1]); l_reg = l_reg * alX + ps; }
    SBAR();
    a1 = MF8(f1, qr[3], a1); f1 = KF(10); PK4(X0, 0, pa0); SBAR();
    a0 = MF8(f2, qr[4], a0); f2 = KF(11); PK4(X0, 8, pa1); SBAR();
    a1 = MF8(f0, qr[4], a1); PK4(X1, 0, pa2); SBAR();
    a0 = MF8(f1, qr[5], a0); PK4(X1, 8, pa3); SBAR();
    a1 = MF8(f2, qr[5], a1); SBAR();
    Y0 = __builtin_bit_cast(f32x16, a0); Y1 = __builtin_bit_cast(f32x16, a1);
#undef KF
}
__device__ __forceinline__ void region2(f32x16* o, f32x16& Y0, f32x16& Y1, float& m_reg, float& alY, bf16x8 pa0, bf16x8 pa1, bf16x8 pa2, bf16x8 pa3, const LAS unsigned char* vp) {
#define VF(n) vfrag(vp, v_rd_off((((n) >> 3) << 1) | ((n) & 1), ((n) >> 1) & 3, 0))
    bf16x8 g0 = VF(0), g1 = VF(1), g2 = VF(2);
    float pm = Y0[0], pn = Y0[1], mc;
    SBAR();
    o[0] = MFB(pa0, g0, o[0]); g0 = VF(3); MAX8(Y0, 0); SBAR();
    o[1] = MFB(pa0, g1, o[1]); g1 = VF(4); MAX8(Y0, 8); SBAR();
    o[0] = MFB(pa1, g2, o[0]); g2 = VF(5); MAX8(Y1, 0); SBAR();
    o[1] = MFB(pa1, g0, o[1]); g0 = VF(6); MAX8(Y1, 8); SBAR();
    o[0] = MFB(pa2, g1, o[0]); g1 = VF(7);
    { pm = fmaxf(pm, pn); auto rr = __builtin_amdgcn_permlane32_swap(__float_as_uint(pm), __float_as_uint(pm), false, false); pm = fmaxf(__uint_as_float(rr[0]), __uint_as_float(rr[1])); pm = (pm - MAGIC) * SC; }
    SBAR();
    o[1] = MFB(pa2, g2, o[1]); g2 = VF(8);
    { const bool ok = __all(pm - m_reg <= THRL); const float mn = ok ? m_reg : fmaxf(m_reg, pm); alY = EX2(m_reg - mn); m_reg = mn; mc = -(mn + MAGIC * SC); }
    SBAR();
    o[0] = MFB(pa3, g0, o[0]); g0 = VF(9); FMA8(Y0, 0); SBAR();
    o[1] = MFB(pa3, g1, o[1]); g1 = VF(10); FMA8(Y0, 8); SBAR();
    o[2] = MFB(pa0, g2, o[2]); g2 = VF(11); FMA8(Y1, 0); SBAR();
    o[3] = MFB(pa0, g0, o[3]); g0 = VF(12); FMA8(Y1, 8); SBAR();
    o[2] = MFB(pa1, g1, o[2]); g1 = VF(13); EXP3(Y0, 0); SBAR();
    o[3] = MFB(pa1, g2, o[3]); g2 = VF(14); EXP3(Y0, 3); SBAR();
    o[2] = MFB(pa2, g0, o[2]); g0 = VF(15); EXP3(Y0, 6); SBAR();
    o[3] = MFB(pa2, g1, o[3]); EXP3(Y0, 9); SBAR();
    o[2] = MFB(pa3, g2, o[2]); EXP3(Y0, 12); SBAR();
    o[3] = MFB(pa3, g0, o[3]); Y0[15] = EX2(Y0[15]);
    asm volatile("" : "+v"(Y0), "+v"(Y1));
    SBAR();
#undef VF
}
__device__ __forceinline__ void body(const signed char* __restrict__ Qb, const signed char* __restrict__ Kh, const bf16_t* __restrict__ Vh, bf16_t* __restrict__ Ob, int seq, LAS unsigned char* L) {
    char* lds = (char*)L;
    int tid_ = threadIdx.x; asm volatile("" : "+v"(tid_));
    const int tid = tid_, wid = tid >> 6, lane = tid & 63, r32 = lane & 31, hi = lane >> 5;
    const int wu = __builtin_amdgcn_readfirstlane(wid);
    float* ws = (float*)(lds + WS_OFF) + wid * 64; float* li_l = ws; float* al_l = ws + 32;
    float m_reg = -1e30f, l_reg = 0; f32x16 o[4] = {}; i32x4 qr[6];
    const signed char* Qw = Qb + (long)(wid * QBLK + r32) * DQ + hi * 16;
#pragma unroll
    for (int ks = 0; ks < 6; ++ks) qr[ks] = *reinterpret_cast<const i32x4*>(Qw + ks * 32);
    i32x16 mg;
#pragma unroll
    for (int r = 0; r < 16; ++r) mg[r] = 0x4B400000;
    asm volatile("" : "+v"(mg));
    unsigned vsa, vsb, ksa, ksb;
    { const int d = (2 * wid) * 64 + lane, S = d >> 5, kk = (S >> 2) * 8 + ((d >> 2) & 7), c8 = (S & 3) * 4 + (d & 3), k = (kk & ~0xC) | ((kk & 4) << 1) | ((kk & 8) >> 1); vsa = (unsigned)(k * 256 + c8 * 16); }
    { const int d = (2 * wid + 1) * 64 + lane, S = d >> 5, kk = (S >> 2) * 8 + ((d >> 2) & 7), c8 = (S & 3) * 4 + (d & 3), k = (kk & ~0xC) | ((kk & 4) << 1) | ((kk & 8) >> 1); vsb = (unsigned)(k * 256 + c8 * 16); }
    { const int d = wid * 64 + lane, row = d / 13, pc = d - row * 13; ksa = (unsigned)(row * DQ + (pc < 12 ? pc : 11) * 16); }
    { const int d = (8 + (wid < 5 ? wid : 4)) * 64 + lane, row = d / 13, pc = d - row * 13; ksb = (unsigned)(row * DQ + (pc < 12 ? pc : 11) * 16); }
#define STAGE(k0, slot) do { const char* _vb = (const char*)Vh + (size_t)(k0) * DV * 2; const char* _kb = (const char*)Kh + (size_t)(k0) * DQ; \
    LAS unsigned char* _vd = L + (slot) * SHM_V + wu * 2048; LAS unsigned char* _kd = L + K_OFF + (slot) * SHM_K + wu * 1024; \
    __builtin_amdgcn_global_load_lds((const unsigned*)(_vb + vsa), (LAS unsigned*)_vd, 16, 0, 0); \
    __builtin_amdgcn_global_load_lds((const unsigned*)(_vb + vsb), (LAS unsigned*)(_vd + 1024), 16, 0, 0); \
    __builtin_amdgcn_global_load_lds((const unsigned*)(_kb + ksa), (LAS unsigned*)_kd, 16, 0, 0); \
    __builtin_amdgcn_global_load_lds((const unsigned*)(_kb + ksb), (LAS unsigned*)(L + K_OFF + (slot) * SHM_K + (8 + (wu < 5 ? wu : 4)) * 1024), 16, 0, 0); } while (0)
#define SWAIT() asm volatile("s_waitcnt vmcnt(0)" ::: "memory")
#define RESC(a) do { if (__any((a) < 1.f)) { if (hi == 0) al_l[r32] = (a); asm volatile("s_waitcnt lgkmcnt(0)" ::: "memory"); \
    _Pragma("unroll") for (int d = 0; d < 4; ++d) _Pragma("unroll") for (int r = 0; r < 16; ++r) o[d][r] *= al_l[crow(r, hi)]; } } while (0)
#define ROT() do { const int _t = b0; b0 = b1; b1 = b2; b2 = _t; } while (0)
    const int kl = K_OFF + r32 * KROW + hi * 16;
    const LAS unsigned char* vl = L + v_rd_base(lane);
#define HALF(X0, X1, alX, Y0, Y1, alY) do { \
    region1(Y0, Y1, X0, X1, alX, l_reg, pa0, pa1, pa2, pa3, lds + kl + b1 * SHM_K, qr, mg); \
    region2(o, Y0, Y1, m_reg, alY, pa0, pa1, pa2, pa3, vl + b0 * SHM_V); \
    RESC(alY); } while (0)
    f32x16 pA0, pA1, pB0, pB1; float alA, alB; bf16x8 pa0, pa1, pa2, pa3; const int NT_ = seq / KVBLK;
    int b0 = 0, b1 = 1, b2 = 2;
    STAGE(0, 0); STAGE(KVBLK, 1); SWAIT(); __syncthreads();
    {
        const char* kb = lds + kl; i32x16 a0, a1;
#pragma unroll
        for (int ks = 0; ks < 6; ++ks) { const i32x4 f0 = *reinterpret_cast<const i32x4*>(kb + ks * 32), f1 = *reinterpret_cast<const i32x4*>(kb + 32 * KROW + ks * 32);
            if (ks == 0) { a0 = MF8(f0, qr[0], mg); a1 = MF8(f1, qr[0], mg); } else { a0 = MF8(f0, qr[ks], a0); a1 = MF8(f1, qr[ks], a1); } }
        pA0 = __builtin_bit_cast(f32x16, a0); pA1 = __builtin_bit_cast(f32x16, a1);
        float pm = pA0[0], pn = pA0[1], mc;
        MAX8(pA0, 0); MAX8(pA0, 8); MAX8(pA1, 0); MAX8(pA1, 8);
        pm = fmaxf(pm, pn); { auto rr = __builtin_amdgcn_permlane32_swap(__float_as_uint(pm), __float_as_uint(pm), false, false); pm = fmaxf(__uint_as_float(rr[0]), __uint_as_float(rr[1])); }
        pm = (pm - MAGIC) * SC; m_reg = pm; alA = 0.f; mc = -(pm + MAGIC * SC);
        FMA8(pA0, 0); FMA8(pA0, 8); FMA8(pA1, 0); FMA8(pA1, 8); EXP4(pA0, 0); EXP4(pA0, 4); EXP4(pA0, 8); EXP4(pA0, 12);
    }
#pragma clang loop unroll(disable)
    for (int j = 1; j + 1 < NT_; j += 2) {
        STAGE((j + 1) * KVBLK, b2);
        HALF(pA0, pA1, alA, pB0, pB1, alB);
        SWAIT(); __syncthreads(); ROT();
        STAGE((j + 2) * KVBLK, b2);
        HALF(pB0, pB1, alB, pA0, pA1, alA);
        SWAIT(); __syncthreads(); ROT();
    }
    HALF(pA0, pA1, alA, pB0, pB1, alB);
    {
        float ps = 0.f, pt = 0.f;
        EXP4(pB1, 0); EXP4(pB1, 4); EXP4(pB1, 8); EXP4(pB1, 12); ADD8(pB0, 0); ADD8(pB0, 8); ADD8(pB1, 0); ADD8(pB1, 8);
        ps += pt; { auto rr = __builtin_amdgcn_permlane32_swap(__float_as_uint(ps), __float_as_uint(ps), false, false); ps = __uint_as_float(rr[0]) + __uint_as_float(rr[1]); } l_reg = l_reg * alB + ps;
        PK4(pB0, 0, pa0); PK4(pB0, 8, pa1); PK4(pB1, 0, pa2); PK4(pB1, 8, pa3);
        const LAS unsigned char* vp = vl + b1 * SHM_V;
#pragma unroll
        for (int d0 = 0; d0 < 4; ++d0) { o[d0] = MFB(pa0, vfrag(vp, v_rd_off(d0, 0, 0)), o[d0]); o[d0] = MFB(pa1, vfrag(vp, v_rd_off(d0, 1, 0)), o[d0]);
            o[d0] = MFB(pa2, vfrag(vp, v_rd_off(d0, 2, 0)), o[d0]); o[d0] = MFB(pa3, vfrag(vp, v_rd_off(d0, 3, 0)), o[d0]); }
    }
    if (hi == 0) li_l[r32] = l_reg; asm volatile("s_waitcnt lgkmcnt(0)" ::: "memory");
    __syncthreads();
    {
        char* ot = lds + wid * 8704;
#pragma unroll
        for (int r = 0; r < 16; ++r) { const int orow = crow(r, hi); const float rl = __builtin_amdgcn_rcpf(li_l[orow]);
#pragma unroll
            for (int d0 = 0; d0 < 4; ++d0) *(bf16_t*)(ot + orow * 272 + (d0 * 32 + r32) * 2) = (bf16_t)(cvt_pk_bf16(o[d0][r] * rl, 0.f) & 0xffffu); }
        asm volatile("s_waitcnt lgkmcnt(0)" ::: "memory");
        bf16_t* Ow = Ob + (long)(wid * QBLK) * 1024;
#pragma unroll
        for (int k = 0; k < 8; ++k) { const int row = 4 * k + (lane >> 4), ch = lane & 15;
            const u32x4 v = *(const u32x4*)(ot + row * 272 + ch * 16);
            *(u32x4*)(Ow + (long)row * 1024 + ch * 8) = v; }
    }
    __syncthreads();
#undef HALF
#undef ROT
#undef STAGE
#undef SWAIT
#undef RESC
}
#undef PK4
#undef FMA8
#undef MAX8
#undef ADD8
#undef EXP3
#undef EXP4
}

typedef short v4i16_t __attribute__((ext_vector_type(4)));
__device__ __forceinline__ s16x4 tr_rd(const LAS unsigned char* p) { return __builtin_bit_cast(s16x4, __builtin_amdgcn_ds_read_tr16_b64_v4i16((LAS v4i16_t*)p)); }
__device__ __forceinline__ int swz16(int r) { return ((r & 3) << 1) | (((r >> 3) & 1) << 3) | ((r >> 2) & 1); }
__device__ __forceinline__ int swzV(int k) { return (k & 3) | (((k >> 3) & 1) << 2); }
#define MFMA16(a, b, c) __builtin_amdgcn_mfma_f32_16x16x32_bf16((a), (b), (c), 0, 0, 0)
__device__ __forceinline__ bf16x8 mk8(u32x2 lo, u32x2 hi) { u32x4 w = {lo.x, lo.y, hi.x, hi.y}; return __builtin_bit_cast(bf16x8, w); }
__device__ __forceinline__ bf16x8 mk8s(s16x4 lo, s16x4 hi) { return (bf16x8){lo[0], lo[1], lo[2], lo[3], hi[0], hi[1], hi[2], hi[3]}; }

__device__ __forceinline__ void ret_scan_unit(Frame& F, int unit, const bf16_t* __restrict__ QK, const bf16_t* __restrict__ V, bf16_t* __restrict__ YF, bf16_t* __restrict__ YB, const float* __restrict__ decay_f, const float* __restrict__ decay_b) {
    constexpr int QS = 544, KS = 544, VS = 288, PS = 144;
    const int vs = unit & 3, dir = (unit >> 2) & 1, h = (unit >> 3) & 3, b = unit >> 5;
    float lg = -expf((dir ? decay_b : decay_f)[h]) * 1.4426950408889634f;
    const int lane = F.lane, w = F.wave, l15 = lane & 15, q4 = lane >> 4, tid = F.tid;
    LAS unsigned char* Qs = F.lds; LAS unsigned char* Ks = F.lds + 64 * QS; LAS unsigned char* Vs = Ks + 2 * 64 * KS; LAS unsigned char* Ps = F.lds + LDS_XTRA;
    const float g64 = exp2f(lg * 64.f);
    f32x4 S[16];
#pragma unroll
    for (int i = 0; i < 16; ++i) S[i] = (f32x4){0.f, 0.f, 0.f, 0.f};
    bf16_t* Y = dir ? YB : YF;
    const int ti1 = w >> 1, tj0 = 2 * (w & 1);
    const LAS unsigned char* q128 = Qs + (16 * ti1 + l15) * QS + q4 * 16;
    const LAS unsigned char* k128 = Ks + (16 * tj0 + l15) * KS + q4 * 16;
    const LAS unsigned char* q64 = Qs + l15 * QS + q4 * 8;
    const LAS unsigned char* ktr = Ks + (4 * q4 + (l15 >> 2)) * KS + (l15 & 3) * 16;
    const LAS unsigned char* vtr = Vs + (4 * q4 + (l15 >> 2)) * VS + w * 32 + (l15 & 3) * 8;
    const LAS unsigned char* pA = Ps + l15 * PS + q4 * 8;
    LAS unsigned char* pW = Ps + (16 * ti1 + l15) * PS + (16 * tj0 + 4 * q4) * 2;
#define RS_ROW0(step) ({ const int _cc = (step) < 4 ? (dir ? 3 - (step) : (step)) : (dir ? 67 - (step) : (step) - 4); (step) < 4 ? NLAT + b * 256 + 64 * _cc : b * 4096 + 64 * _cc; })
    const int wu = __builtin_amdgcn_readfirstlane(w);
    unsigned qo[5], ko[5], vo[3];
#pragma unroll
    for (int i = 0; i < 5; ++i) { int ins = i * 8 + w; ins = ins > 33 ? 33 : ins; const int d = ins * 64 + lane, row = d / 34, pc = d - 34 * row; qo[i] = (unsigned)(row * 4096 + (pc < 32 ? pc : 31) * 16); }
#pragma unroll
    for (int i = 0; i < 5; ++i) { int ins = i * 8 + w; ins = ins > 33 ? 33 : ins; const int d = ins * 64 + lane, row = d / 34, pc = d - 34 * row; ko[i] = (unsigned)(row * 4096 + (pc < 32 ? pc : 31) * 16); }
#pragma unroll
    for (int i = 0; i < 3; ++i) { int ins = i * 8 + w; ins = ins > 17 ? 17 : ins; const int d = ins * 64 + lane, row = d / 18, pc = d - 18 * row; vo[i] = (unsigned)(row * 4096 + (pc < 16 ? pc : 15) * 16); }
    const char* Qg = (const char*)(QK + 256 * h); const char* Kg = (const char*)(QK + 1024 + 256 * h); const char* Vg = (const char*)(V + 512 * h + 128 * vs);
#define RS_DMA_Q(R0) do { _Pragma("unroll") for (int _i = 0; _i < 5; ++_i) { const int _s = _i * 8 + wu; \
        __builtin_amdgcn_global_load_lds((const unsigned*)(Qg + (size_t)(R0) * 4096 + qo[_i]), (LAS unsigned*)(Qs + (_s > 33 ? 33 : _s) * 1024), 16, 0, 0); } } while (0)
#define RS_DMA_K(R0, kb) do { _Pragma("unroll") for (int _i = 0; _i < 5; ++_i) { const int _s = _i * 8 + wu; \
        __builtin_amdgcn_global_load_lds((const unsigned*)(Kg + (size_t)(R0) * 4096 + ko[_i]), (LAS unsigned*)(Ks + (kb) + (_s > 33 ? 33 : _s) * 1024), 16, 0, 0); } } while (0)
#define RS_DMA_V(R0) do { _Pragma("unroll") for (int _i = 0; _i < 3; ++_i) { const int _s = _i * 8 + wu; \
        __builtin_amdgcn_global_load_lds((const unsigned*)(Vg + (size_t)(R0) * 4096 + vo[_i]), (LAS unsigned*)(Vs + (_s > 17 ? 17 : _s) * 1024), 16, 0, 0); } } while (0)
    { const int R0 = RS_ROW0(0); RS_DMA_Q(R0); RS_DMA_K(R0, 0); RS_DMA_V(R0); }
    asm volatile("s_waitcnt vmcnt(0)" ::: "memory");
    __syncthreads();
    for (int step = 0; step < 68; ++step) {
        const int R0 = RS_ROW0(step), R1 = RS_ROW0(step + 1 < 68 ? step + 1 : step), kbo = (step & 1) * (64 * KS);
        const bool more = step + 1 < 68;
        if (more) { RS_DMA_K(R1, (64 * KS) - kbo); }
#define SB0() __builtin_amdgcn_sched_barrier(0)
        f32x4 p0 = (f32x4){0.f, 0.f, 0.f, 0.f}, p1 = p0;
        {
            const LAS unsigned char* k128b = k128 + kbo;
            bf16x8 qa[8], kb0[8], kb1[8];
#define A1RD(s_) do { qa[s_] = *(const LAS bf16x8*)(q128 + (s_) * 64); kb0[s_] = *(const LAS bf16x8*)(k128b + (s_) * 64); kb1[s_] = *(const LAS bf16x8*)(k128b + 16 * KS + (s_) * 64); } while (0)
            A1RD(0); A1RD(1); A1RD(2);
#pragma unroll
            for (int ks = 0; ks < 8; ++ks) {
                if (ks + 3 < 8) A1RD(ks + 3);
                SB0();
                p0 = MFMA16(kb0[ks], qa[ks], p0); p1 = MFMA16(kb1[ks], qa[ks], p1);
                SB0();
            }
#undef A1RD
        }
        {
            const int dbase = dir ? (16 * tj0 + 4 * q4) - (16 * ti1 + l15) : (16 * ti1 + l15) - (16 * tj0 + 4 * q4);
#pragma unroll
            for (int t = 0; t < 2; ++t) {
                const f32x4 pv = t ? p1 : p0; float val[4];
#pragma unroll
                for (int rg = 0; rg < 4; ++rg) { const int d = dir ? dbase + 16 * t + rg : dbase - 16 * t - rg;
                    val[rg] = d >= 0 ? pv[rg] * __builtin_amdgcn_exp2f(lg * (float)d) : 0.f; }
                u32x2 pw; pw.x = cvt_pk_bf16(val[0], val[1]); pw.y = cvt_pk_bf16(val[2], val[3]);
                *(LAS u32x2*)(pW + t * 32) = pw;
            }
        }
        f32x4 y[4];
#pragma unroll
        for (int ti = 0; ti < 4; ++ti) y[ti] = (f32x4){0.f, 0.f, 0.f, 0.f};
        {
            const LAS unsigned char* qrow = Qs + l15 * QS + q4 * 16;
            bf16x8 qf[8][4];
#define A2RD(s_) do { _Pragma("unroll") for (int ti = 0; ti < 4; ++ti) qf[s_][ti] = *(const LAS bf16x8*)(qrow + ti * 16 * QS + (s_) * 64); } while (0)
            A2RD(0);
#pragma unroll
            for (int ks = 0; ks < 8; ++ks) {
                if (ks < 7) A2RD(ks + 1);
                u32x4 bw; bw.x = cvt_pk_bf16(S[2 * ks][0], S[2 * ks][1]); bw.y = cvt_pk_bf16(S[2 * ks][2], S[2 * ks][3]); bw.z = cvt_pk_bf16(S[2 * ks + 1][0], S[2 * ks + 1][1]); bw.w = cvt_pk_bf16(S[2 * ks + 1][2], S[2 * ks + 1][3]);
                const bf16x8 bfr = __builtin_bit_cast(bf16x8, bw);
                SB0();
#pragma unroll
                for (int ti = 0; ti < 4; ++ti) y[ti] = MFMA16(bfr, qf[ks][ti], y[ti]);
                SB0();
            }
#undef A2RD
        }
#pragma unroll
        for (int ti = 0; ti < 4; ++ti) { const int qi = 16 * ti + l15; y[ti] = y[ti] * __builtin_amdgcn_exp2f(lg * (float)(dir ? 64 - qi : qi + 1)); }
        if (more) asm volatile("s_waitcnt vmcnt(5) lgkmcnt(0)" ::: "memory"); else asm volatile("s_waitcnt vmcnt(0) lgkmcnt(0)" ::: "memory");
        __builtin_amdgcn_s_barrier(); asm volatile("" ::: "memory");
        if (more) { RS_DMA_Q(R1); }
        bf16x8 vf[2];
#pragma unroll
        for (int ks2 = 0; ks2 < 2; ++ks2) {
            const s16x4 lo = tr_rd(vtr + ks2 * 32 * VS);
            const s16x4 hi = tr_rd(vtr + ks2 * 32 * VS + 16 * VS);
            vf[ks2] = mk8s(lo, hi);
        }
#pragma unroll
        for (int ks2 = 0; ks2 < 2; ++ks2)
#pragma unroll
            for (int ti = 0; ti < 4; ++ti) {
                const u32x2 lo = *(const LAS u32x2*)(pA + ti * 16 * PS + ks2 * 64);
                const u32x2 hi = *(const LAS u32x2*)(pA + ti * 16 * PS + ks2 * 64 + 32);
                y[ti] = MFMA16(vf[ks2], mk8(lo, hi), y[ti]);
            }
        const LAS unsigned char* ktrb = ktr + kbo;
        SB0(); asm volatile("s_nop 15\n\ts_nop 7" ::: "memory"); SB0();
        {
            bf16_t* yp = Y + (size_t)(R0 + l15) * 2048 + 512 * h + 128 * vs + 16 * w + 4 * q4;
#pragma unroll
            for (int ti = 0; ti < 4; ++ti) { u32x2 yw; yw.x = cvt_pk_bf16(y[ti][0], y[ti][1]); yw.y = cvt_pk_bf16(y[ti][2], y[ti][3]); *(u32x2*)(yp + (size_t)(16 * ti) * 2048) = yw; }
        }
        bf16x8 vp[2];
        {
            const float dk0 = __builtin_amdgcn_exp2f(lg * (float)(dir ? 4 * q4 : 63 - 4 * q4));
            float dkj[8];
#pragma unroll
            for (int j = 0; j < 8; ++j) { const int dkk = (j & 3) + 16 * (j >> 2); dkj[j] = __builtin_amdgcn_exp2f(lg * (float)(dir ? dkk : -dkk)); }
            const float dk32 = __builtin_amdgcn_exp2f(lg * (float)(dir ? 32 : -32));
#pragma unroll
            for (int ks2 = 0; ks2 < 2; ++ks2) {
                const float bs = ks2 ? dk0 * dk32 : dk0;
                const u32x4 vw = __builtin_bit_cast(u32x4, vf[ks2]); u32x4 o;
                o.x = cvt_pk_bf16(bflo(vw.x) * (bs * dkj[0]), bfhi(vw.x) * (bs * dkj[1])); o.y = cvt_pk_bf16(bflo(vw.y) * (bs * dkj[2]), bfhi(vw.y) * (bs * dkj[3]));
                o.z = cvt_pk_bf16(bflo(vw.z) * (bs * dkj[4]), bfhi(vw.z) * (bs * dkj[5])); o.w = cvt_pk_bf16(bflo(vw.w) * (bs * dkj[6]), bfhi(vw.w) * (bs * dkj[7]));
                vp[ks2] = __builtin_bit_cast(bf16x8, o);
            }
        }
        {
            s16x4 kl[16][2], kh[16][2];
#define B2RD(d_) do { _Pragma("unroll") for (int ks2 = 0; ks2 < 2; ++ks2) { kl[d_][ks2] = tr_rd(ktrb + ks2 * 32 * KS + ((d_) >> 1) * 64 + ((d_) & 1) * 8); kh[d_][ks2] = tr_rd(ktrb + ks2 * 32 * KS + 16 * KS + ((d_) >> 1) * 64 + ((d_) & 1) * 8); } } while (0)
            B2RD(0); B2RD(1);
#pragma unroll
            for (int dt = 0; dt < 16; ++dt) {
                if (dt + 2 < 16) B2RD(dt + 2);
                S[dt] = S[dt] * g64;
                SB0();
#pragma unroll
                for (int ks2 = 0; ks2 < 2; ++ks2) S[dt] = MFMA16(mk8s(kl[dt][ks2], kh[dt][ks2]), vp[ks2], S[dt]);
                SB0();
            }
#undef B2RD
        }
#undef SB0
        asm volatile("s_waitcnt vmcnt(0) lgkmcnt(0)" ::: "memory");
        __builtin_amdgcn_s_barrier(); asm volatile("" ::: "memory");
        if (more) { RS_DMA_V(R1); }
    }
#undef RS_ROW0
#undef RS_DMA_Q
#undef RS_DMA_K
#undef RS_DMA_V
}

__device__ __forceinline__ void readout_row(const bf16_t* yf, const bf16_t* yb, const unsigned char* g, signed char* o8, float* osp, int lane) {
    u32x4 a[4], bq[4]; u32x2 gf[4], gb[4];
#pragma unroll
    for (int hh = 0; hh < 4; ++hh) { a[hh] = *(const u32x4*)(yf + 512 * hh + 8 * lane); bq[hh] = *(const u32x4*)(yb + 512 * hh + 8 * lane);
        gf[hh] = *(const u32x2*)(g + 512 * hh + 8 * lane); gb[hh] = *(const u32x2*)(g + 2048 + 512 * hh + 8 * lane); }
    float sa[4], sb[4];
#pragma unroll
    for (int hh = 0; hh < 4; ++hh) { float x = 0.f, y = 0.f;
#pragma unroll
        for (int i = 0; i < 4; ++i) { const float a0 = bflo(a[hh][i]), a1 = bfhi(a[hh][i]), b0 = bflo(bq[hh][i]), b1 = bfhi(bq[hh][i]); x += a0 * a0 + a1 * a1; y += b0 * b0 + b1 * b1; }
        sa[hh] = x; sb[hh] = y; }
#pragma unroll
    for (int of = 1; of < 64; of <<= 1) {
#pragma unroll
        for (int hh = 0; hh < 4; ++hh) { sa[hh] += __shfl_xor(sa[hh], of); sb[hh] += __shfl_xor(sb[hh], of); }
    }
    float ov[4][8]; float m = 0.f;
#pragma unroll
    for (int hh = 0; hh < 4; ++hh) {
        const float ra = rsqrtf(sa[hh] * (1.f / 512.f) + EPS), rb = rsqrtf(sb[hh] * (1.f / 512.f) + EPS);
#pragma unroll
        for (int i = 0; i < 4; ++i) {
            const f32x2 gfv = (i & 1) ? __builtin_amdgcn_cvt_pk_f32_fp8((int)gf[hh][i >> 1], true) : __builtin_amdgcn_cvt_pk_f32_fp8((int)gf[hh][i >> 1], false);
            const f32x2 gbv = (i & 1) ? __builtin_amdgcn_cvt_pk_f32_fp8((int)gb[hh][i >> 1], true) : __builtin_amdgcn_cvt_pk_f32_fp8((int)gb[hh][i >> 1], false);
            ov[hh][2 * i] = siluf(gfv.x) * bflo(a[hh][i]) * ra + siluf(gbv.x) * bflo(bq[hh][i]) * rb;
            ov[hh][2 * i + 1] = siluf(gfv.y) * bfhi(a[hh][i]) * ra + siluf(gbv.y) * bfhi(bq[hh][i]) * rb;
            m = fmaxf(m, fmaxf(fabsf(ov[hh][2 * i]), fabsf(ov[hh][2 * i + 1])));
        }
    }
    m = wave_max(m);
    const float sc = m > 0.f ? m * (1.f / 127.f) : 1.f, inv = 1.f / sc;
#pragma unroll
    for (int hh = 0; hh < 4; ++hh) { u32x2 w; w.x = pack_i8x4(ov[hh][0] * inv, ov[hh][1] * inv, ov[hh][2] * inv, ov[hh][3] * inv); w.y = pack_i8x4(ov[hh][4] * inv, ov[hh][5] * inv, ov[hh][6] * inv, ov[hh][7] * inv);
        *(u32x2*)(o8 + 512 * hh + 8 * lane) = w; }
    if (lane == 0) *osp = sc;
}

__global__ void __launch_bounds__(NTHR, 2) fwd_kernel(Args args) {
    extern __shared__ __attribute__((aligned(16))) unsigned char lds_raw[];
    Frame F;
    F.lds = (LAS unsigned char*)lds_raw;
    F.tid = threadIdx.x; F.lane = F.tid & 63; F.wave = __builtin_amdgcn_readfirstlane(F.tid >> 6);
    F.G = gridDim.x; { const int bx = blockIdx.x; F.vcu = (F.G % 8 == 0) ? (bx % 8) * (F.G / 8) + bx / 8 : bx; }
    F.ws = args.ws; F.ctl = (unsigned*)(args.ws + WS_CTL);
    volatile LAS unsigned* MISC = (volatile LAS unsigned*)(F.lds + LDSCTL_OFF);
    for (int u = F.tid; u < (LDS_BYTES - LDSCTL_OFF) / 4; u += NTHR) ((LAS unsigned*)(F.lds + LDSCTL_OFF))[u] = 0u;
    __syncthreads();
    XcdBarrier bar; bar.bar = F.ctl + CW_BAR; bar.x = 0; bar.st = nullptr;
    if (MK_ONE_LAUNCH) bar = xcd_barrier_post(F.ctl + CW_BAR, MISC + 8);
    const int lo = args.ph_lo, hi = args.ph_hi;
#ifndef PHMASK
#define PHMASK 0xffffffffu
#endif
#define IN(k) (((PHMASK >> (k)) & 1u) && lo <= (k) && (k) < hi)
#define SEAM(k) do { if (MK_ONE_LAUNCH && IN((k) + 1)) xcd_barrier(bar); } while (0)

    const float* x = (const float*)args.in[0]; const float* c = (const float*)args.in[1]; const float* ctx = (const float*)args.in[2]; const float* c_ctx = (const float*)args.in[3];
    const float* ada_w = (const float*)args.in[4]; const float* ada_b = (const float*)args.in[5]; const float* norm_mix = (const float*)args.in[6]; const float* norm_ffn = (const float*)args.in[7];
    float* MOD = (float*)(F.ws + WS_MOD);
    bf16_t* H = (bf16_t*)(F.ws + WS_H);
    signed char* H8 = (signed char*)(F.ws + WS_H8); float* HS = (float*)(F.ws + WS_HS); signed char* O8 = (signed char*)(F.ws + WS_O); float* OS = (float*)(F.ws + WS_OS);
    bf16_t* XB = (bf16_t*)(F.ws + WS_XB);
    float* out = args.out;
    const int gw = F.vcu * NWAVES + F.wave, NGW = F.G * NWAVES;

    if (IN(0)) {
        mod_vectors(F, c, c_ctx, ada_w, ada_b, MOD);
        __syncthreads();
        rope_tables(F, (f32x2*)(F.ws + WS_TABR), (f32x2*)(F.ws + WS_TABM));
        {
        int cb = 0;
        conv_job(F, cb, (const float*)args.in[14], (bf16_t*)(F.ws + WS_W_QB), 384, 1536, 1536, 0, 1, 0, 0, (const float*)args.in[13]);
        conv_job(F, cb, (const float*)args.in[16], (bf16_t*)(F.ws + WS_W_KVB), 256, 2048, 2048, 0, 1, 0, 0, (const float*)args.in[15]);
        conv_job(F, cb, (const float*)args.in[19], (bf16_t*)(F.ws + WS_W_MO), 1024, 1024, 1024, 0, 1, 0, 0);
        conv_job(F, cb, (const float*)args.in[20], (bf16_t*)(F.ws + WS_W_RT), 1024, 64, 256, 3, 2, (size_t)1024 * 64, (size_t)256 * 1024);
        conv_job(F, cb, (const float*)args.in[25], (bf16_t*)(F.ws + WS_W_SD), 256, 1024, 1024, 0, 2, (size_t)256 * 1024, (size_t)1024 * 256);
        conv_job(F, cb, (const float*)args.in[23], (bf16_t*)(F.ws + WS_W_ED), 256, 1024, 1024, 0, 64, (size_t)256 * 1024, (size_t)1024 * 256);
        __syncthreads();
        int c8 = 0;
        conv8_job<2, true>(F, c8, (const float*)args.in[8], (signed char*)(F.ws + WS_W_RI8), (float*)(F.ws + WS_CS_RI), 1024, 8192, 8192, 1, 1, 0);
        conv8_job<4, false>(F, c8, (const float*)args.in[11], (signed char*)(F.ws + WS_W_RO8), (float*)(F.ws + WS_CS_RO), 2048, 1024, 1024, 0, 1, 0);
        conv8_job<2, true>(F, c8, (const float*)args.in[12], (signed char*)(F.ws + WS_W_MI8), (float*)(F.ws + WS_CS_MI), 1024, 704, 768, 3, 1, 0);
        conv8_job<2, true>(F, c8, (const float*)args.in[24], (signed char*)(F.ws + WS_W_SGU8), (float*)(F.ws + WS_CS_SGU), 1024, 512, 512, 2, 2, (size_t)1024 * 512);
        conv8_job<2, true>(F, c8, (const float*)args.in[22], (signed char*)(F.ws + WS_W_EGU8), (float*)(F.ws + WS_CS_EGU), 1024, 512, 512, 2, 64, (size_t)1024 * 512);
        }
        SEAM(0);
    }
    if (IN(1)) {
        for (int rep = 0; rep < PROBE_REPS(1); ++rep)
        for (int r = gw; r < NT; r += NGW) {
            const float* xr = r < NLAT ? x + (size_t)r * DM : ctx + (size_t)(r - NLAT) * DM;
            const float* md = MOD + (size_t)(0 * 9 + mod_row_of(r)) * 6144;
            norm_mod_row(xr, norm_mix, md, md + 1024, nullptr, H8 + (size_t)r * DM, HS + r, F.lane);
        }
        SEAM(1);
    }
    bf16_t* QKb = (bf16_t*)(F.ws + WS_QK); bf16_t* Vb = (bf16_t*)(F.ws + WS_V); bf16_t* Gb = (bf16_t*)(F.ws + WS_G);
    bf16_t* YFb = (bf16_t*)(F.ws + WS_YF); bf16_t* YBb = (bf16_t*)(F.ws + WS_YB); bf16_t* Ob = (bf16_t*)(F.ws + WS_O);
    if (IN(2)) {
        g8::DenseSched S; S.init(H8, 512, F.ws + WS_W_RI8, 512, NT, RET_IN, F.G, (int)blockIdx.x, HS, (const float*)(F.ws + WS_CS_RI));
        EpiRetProj E{QKb, Vb, Gb, (const f32x4*)(F.ws + WS_TABR)};
        g8::gemm_phase<true>(F.lds, 512, 512, 512, S, E);
        SEAM(2);
    }
    if (IN(3)) {
        for (int rep = 0; rep < PROBE_REPS(3); ++rep)
        for (int u = F.vcu; u < 256; u += F.G) ret_scan_unit(F, u, QKb, Vb, YFb, YBb, (const float*)args.in[9], (const float*)args.in[10]);
        SEAM(3);
    }
    if (IN(4)) {
        for (int rep = 0; rep < PROBE_REPS(4); ++rep)
        for (int r = gw; r < NT; r += NGW) readout_row(YFb + (size_t)r * 2048, YBb + (size_t)r * 2048, (const unsigned char*)Gb + (size_t)r * 4096, O8 + (size_t)r * 2048, OS + r, F.lane);
        SEAM(4);
    }
    if (IN(5)) {
        g8::DenseSched S; S.init(O8, 1024, F.ws + WS_W_RO8, 1024, NT, DM, F.G, (int)blockIdx.x, OS, (const float*)(F.ws + WS_CS_RO));
        EpiResid<false> E{x, ctx, XB, MOD + 2 * 1024};
        g8::gemm_phase<true>(F.lds, 1024, 1024, 1024, S, E);
        SEAM(5);
    }
    float* LOGIT = (float*)(F.ws + WS_LOGIT); int* RTP = (int*)(F.ws + WS_RT_P); int* LIST = (int*)(F.ws + WS_LIST); float* RTW = (float*)(F.ws + WS_LISTW); float* LISTS = (float*)(F.ws + WS_LISTS);
    bf16_t* ACT = (bf16_t*)(F.ws + WS_ACT); unsigned char* YS = (unsigned char*)(F.ws + WS_YS);
    const float* router_bias = (const float*)args.in[21];
    if (IN(6)) {
        for (int c0 = F.vcu; c0 < NT / 136; c0 += F.G) { norm_router_block(F, 0, c0 * 136, 136, XB, norm_ffn, MOD, (const bf16_t*)(F.ws + WS_W_RT), H8, HS, LOGIT);
            route_block(F, 0, c0 * 136, 136, LOGIT, router_bias, LIST, RTW, RTP, HS, LISTS); }
        SEAM(8);
    }
    if (IN(9)) {
        build_tpre(F, 0, NT);
        g8::GroupSched<true> S; S.tpre = (const LAS int*)(F.lds + LDS_TPRE); S.cnts = (const LAS int*)(F.lds + LDS_CNTS);
        S.A = (const char*)H8; S.B = (const char*)(F.ws + WS_W_EGU8); S.Bsh = (const char*)(F.ws + WS_W_SGU8); S.list = LIST; S.lda = 512; S.ldb = 512; S.ncu = 2; S.bexp = (size_t)512 * 1024; S.G = F.G; S.c = F.vcu; S.total = S.tpre[65] * 2;
        S.rs = HS; S.rsls = LISTS; S.cs = (const float*)(F.ws + WS_CS_EGU); S.cssh = (const float*)(F.ws + WS_CS_SGU); S.ncols = 512;
        EpiAct E{ACT};
        g8::gemm_phase<true>(F.lds, 512, 512, 512, S, E);
        SEAM(9);
    }
    if (IN(10)) {
        build_tpre(F, 0, NT);
        g8::GroupSched<false> S; S.tpre = (const LAS int*)(F.lds + LDS_TPRE); S.cnts = (const LAS int*)(F.lds + LDS_CNTS);
        S.A = (const char*)ACT; S.B = (const char*)(F.ws + WS_W_ED); S.Bsh = (const char*)(F.ws + WS_W_SD); S.list = nullptr; S.lda = 256; S.ldb = 256; S.ncu = 4; S.bexp = (size_t)1024 * 256 * 2; S.G = F.G; S.c = F.vcu; S.total = S.tpre[65] * 4; S.rs = nullptr; S.rsls = nullptr; S.cs = nullptr; S.cssh = nullptr; S.ncols = 0;
        EpiDown E{YS}; g8::gemm_phase<false>(F.lds, 256, 256, 256, S, E);
        SEAM(10);
    }
    if (IN(11)) {
        build_tpre(F, 0, NT);
        for (int r = gw; r < NT; r += NGW) {
            bf16_t* xr = XB + (size_t)r * DM;
            const float* md0 = MOD + (size_t)(0 * 9 + mod_row_of(r)) * 6144; const float* md1 = MOD + (size_t)(1 * 9 + mod_row_of(r)) * 6144;
            combine_row<false>(F, RTP, RTW, r, YS, xr, nullptr, xr, md0 + 5 * 1024, true, norm_mix + DM, md1, md1 + 1024, H8 + (size_t)r * DM, HS + r);
        }
        __syncthreads();
        int cb = 0;
        conv_job(F, cb, (const float*)args.in[23] + (size_t)64 * 256 * 1024, (bf16_t*)(F.ws + WS_W_ED), 256, 1024, 1024, 0, 64, (size_t)256 * 1024, (size_t)1024 * 256);
        __syncthreads();
        int c8 = 0;
        conv8_job<2, true>(F, c8, (const float*)args.in[22] + (size_t)64 * 1024 * 512, (signed char*)(F.ws + WS_W_EGU8), (float*)(F.ws + WS_CS_EGU), 1024, 512, 512, 2, 64, (size_t)1024 * 512);
        SEAM(11);
    }
    bf16_t* Abuf = (bf16_t*)(F.ws + WS_A); bf16_t* AQN = (bf16_t*)(F.ws + WS_AQN); bf16_t* AKVN = (bf16_t*)(F.ws + WS_AKVN); bf16_t* KROPE = (bf16_t*)(F.ws + WS_KROPE);
    bf16_t* QRAW = (bf16_t*)(F.ws + WS_QRAW); bf16_t* KVRAW = (bf16_t*)(F.ws + WS_KVRAW); signed char* QF = (signed char*)(F.ws + WS_QF); signed char* KF = (signed char*)(F.ws + WS_KF); bf16_t* VF = (bf16_t*)(F.ws + WS_VF);
    bf16_t* OATT = (bf16_t*)(F.ws + WS_OATT);
    const f32x2* TABM = (const f32x2*)(F.ws + WS_TABM);
    if (IN(12)) {
        g8::DenseSched S; S.init(H8, 512, F.ws + WS_W_MI8, 512, NT, MLA_INP, F.G, (int)blockIdx.x, HS, (const float*)(F.ws + WS_CS_MI)); EpiStore E{Abuf, MLA_INP}; g8::gemm_phase<true>(F.lds, 512, 512, 512, S, E);
        SEAM(12);
    }
    if (IN(14)) {
        for (int rep = 0; rep < 1; ++rep) {
        { g8::DenseSched S; S.init(Abuf, MLA_INP, F.ws + WS_W_QB, MLA_QR, NLAT, 1536, F.G, (int)blockIdx.x); EpiStore E{QRAW, 1536}; g8::gemm_phase<false>(F.lds, MLA_QR, MLA_INP, MLA_QR, S, E); if ((PROBE_MASK >> 14) & 1u) g8::gemm_phase<false>(F.lds, MLA_QR, MLA_QR, MLA_QR, S, E); }
        { g8::DenseSched S; S.init(Abuf + MLA_QR, MLA_INP, F.ws + WS_W_KVB, MLA_KVR, NT, 2048, F.G, (int)blockIdx.x); EpiStore E{KVRAW, 2048}; g8::gemm_phase<false>(F.lds, MLA_KVR, MLA_INP, MLA_KVR, S, E); if ((PROBE_MASK >> 14) & 1u) g8::gemm_phase<false>(F.lds, MLA_KVR, MLA_KVR, MLA_KVR, S, E); }
        }
        SEAM(14);
    }
    if (IN(15)) {
        for (int rep = 0; rep < PROBE_REPS(15); ++rep)
        for (int r = gw; r < NT; r += 2 * NGW) {
            mla_final_row(r, Abuf, QRAW, KVRAW, (const float*)args.in[17], (const float*)args.in[18], TABM, QF, KF, VF, F.lane);
            if (r + NGW < NT) mla_final_row(r + NGW, Abuf, QRAW, KVRAW, (const float*)args.in[17], (const float*)args.in[18], TABM, QF, KF, VF, F.lane); }
        SEAM(15);
    }
    if (IN(16)) {
        for (int rep = 0; rep < PROBE_REPS(16); ++rep)
        for (int u = F.vcu; u < 1024; u += F.G) { const int bh = u >> 4, qb = u & 15, b = bh >> 3, h = bh & 7;
            att::body(QF + ((size_t)bh * 4096 + qb * 256) * 192, KF + (size_t)bh * SKV * 192, VF + (size_t)bh * SKV * 128, OATT + ((size_t)b * 4096 + qb * 256) * 1024 + h * 128, SKV, F.lds); }
        SEAM(16);
    }
    if (IN(17)) {
        g8::DenseSched S; S.init(OATT, DM, F.ws + WS_W_MO, DM, NLAT, DM, F.G, (int)blockIdx.x); EpiResid<true> E{nullptr, nullptr, XB, MOD + 9 * 6144 + 2 * 1024}; g8::gemm_phase<false>(F.lds, DM, DM, DM, S, E);
        SEAM(17);
    }
    if (IN(18)) {
        for (int c0 = F.vcu; c0 < NLAT / 128; c0 += F.G) { norm_router_block(F, 1, c0 * 128, 128, XB, norm_ffn + DM, MOD + (size_t)9 * 6144, (const bf16_t*)(F.ws + WS_W_RT) + (size_t)256 * 1024, H8, HS, LOGIT);
            route_block(F, 1, c0 * 128, 128, LOGIT, router_bias + 64, LIST, RTW, RTP, HS, LISTS); }
        SEAM(20);
    }
    if (IN(21)) {
        build_tpre(F, 1, NLAT);
        g8::GroupSched<true> S; S.tpre = (const LAS int*)(F.lds + LDS_TPRE); S.cnts = (const LAS int*)(F.lds + LDS_CNTS);
        S.A = (const char*)H8; S.B = (const char*)(F.ws + WS_W_EGU8); S.Bsh = (const char*)(F.ws + WS_W_SGU8 + (size_t)512 * 1024); S.list = LIST; S.lda = 512; S.ldb = 512; S.ncu = 2; S.bexp = (size_t)512 * 1024; S.G = F.G; S.c = F.vcu; S.total = S.tpre[65] * 2;
        S.rs = HS; S.rsls = LISTS; S.cs = (const float*)(F.ws + WS_CS_EGU); S.cssh = (const float*)(F.ws + WS_CS_SGU) + 512; S.ncols = 512;
        EpiAct E{ACT};
        g8::gemm_phase<true>(F.lds, 512, 512, 512, S, E);
        SEAM(21);
    }
    if (IN(22)) {
        build_tpre(F, 1, NLAT);
        g8::GroupSched<false> S; S.tpre = (const LAS int*)(F.lds + LDS_TPRE); S.cnts = (const LAS int*)(F.lds + LDS_CNTS);
        S.A = (const char*)ACT; S.B = (const char*)(F.ws + WS_W_ED); S.Bsh = (const char*)(F.ws + WS_W_SD + (size_t)1024 * 256 * 2); S.list = nullptr; S.lda = 256; S.ldb = 256; S.ncu = 4; S.bexp = (size_t)1024 * 256 * 2; S.G = F.G; S.c = F.vcu; S.total = S.tpre[65] * 4; S.rs = nullptr; S.rsls = nullptr; S.cs = nullptr; S.cssh = nullptr; S.ncols = 0;
        EpiDown E{YS}; g8::gemm_phase<false>(F.lds, 256, 256, 256, S, E);
        SEAM(22);
    }
    if (IN(23)) {
        build_tpre(F, 1, NLAT);
        for (int r = gw; r < NLAT; r += NGW) { const float* md1 = MOD + (size_t)(1 * 9 + (r >> 12)) * 6144;
            combine_row<true>(F, RTP, RTW, r, YS, XB + (size_t)r * DM, out + (size_t)r * DM, nullptr, md1 + 5 * 1024, false, norm_mix, md1, md1, H8, HS); }
    }
#undef IN
#undef SEAM
}

constexpr int N_PHASES = 24;
extern "C" void kernel_launch(void* const* d_in, const int* in_sizes, int n_in, void* d_out, int out_size, void* d_ws, size_t ws_size, hipStream_t stream) {
    static int grid = 0;
    if (grid == 0) {
        if (n_in != 26 || out_size != NLAT * DM || ws_size < WS_END) { fprintf(stderr, "kernel_launch: unexpected shapes: n_in %d out %d ws %zu (need %zu)\n", n_in, out_size, ws_size, (size_t)WS_END); grid = -1; return; }
        int dev = 0, cus = 0, per_cu = 0;
        if (hipGetDevice(&dev) != hipSuccess || hipDeviceGetAttribute(&cus, hipDeviceAttributeMultiprocessorCount, dev) != hipSuccess) { grid = -1; return; }
        if (hipFuncSetAttribute((const void*)fwd_kernel, hipFuncAttributeMaxDynamicSharedMemorySize, LDS_BYTES) != hipSuccess) { fprintf(stderr, "kernel_launch: hipFuncSetAttribute failed\n"); grid = -1; return; }
        if (hipOccupancyMaxActiveBlocksPerMultiprocessor(&per_cu, (const void*)fwd_kernel, NTHR, LDS_BYTES) != hipSuccess || per_cu < 1) fprintf(stderr, "kernel_launch: occupancy query says %d\n", per_cu);
        (void)hipGetLastError();
        grid = cus;
    }
    if (grid < 0) return;
    (void)hipMemsetAsync((char*)d_ws + WS_CTL, 0, CTL_ZERO_BYTES, stream);
    Args a{};
    for (int i = 0; i < 26; ++i) a.in[i] = d_in[i];
    a.out = (float*)d_out; a.ws = (unsigned char*)d_ws;
    const int last = N_PHASES < MK_LAST_PHASE ? N_PHASES : MK_LAST_PHASE;
    if (MK_ONE_LAUNCH) {
        a.ph_lo = 0; a.ph_hi = last;
        hipLaunchKernelGGL(fwd_kernel, dim3(grid), dim3(NTHR), LDS_BYTES, stream, a);
    } else {
        for (int p = 0; p < last; ++p) { a.ph_lo = p; a.ph_hi = p + 1; hipLaunchKernelGGL(fwd_kernel, dim3(grid), dim3(NTHR), LDS_BYTES, stream, a); }
    }
    const hipError_t le = hipPeekAtLastError();
    if (le != hipSuccess) fprintf(stderr, "kernel_launch: launch failed: %s\n", hipGetErrorName(le));
}
```
